# Optimizing an MI355X kernel written in HIP

```python
import math
import jax
import jax.numpy as jnp
from jax import lax
import numpy as np

D_MODEL = 2048
BATCH = 4
SEQ = 2048
DEPTH = 4

CHUNK = 64
N_PREV_CHUNKS = 8
BAND_CHUNKS = N_PREV_CHUNKS + 1
Q_BLOCK = 128
ROPE_THETA = 500000.0
PLE_DIM = 256
D_FF = 5632
NORM_EPS = 1e-6
NEG_INF = -1e30

A_HEADS = 8
A_HEAD_DIM = 128
A_WIDTH = A_HEADS * A_HEAD_DIM
REL_FUTURE = CHUNK - 1
REL_PAST_CLIP = 128
REL_TABLE = REL_FUTURE + REL_PAST_CLIP + 1

B_HEADS = 8
B_NOPE_DIM = 128
B_ROPE_DIM = 64
B_V_DIM = 128
B_Q_LORA = 512
B_KV_LORA = 256
B_WIDTH = B_HEADS * B_V_DIM

AB_IN = 3 * A_WIDTH + B_Q_LORA + B_KV_LORA + B_ROPE_DIM
AB_OUT = A_WIDTH + B_WIDTH

C_HEADS = 8
C_HEAD_DIM = 128
C_V_DIM = 2 * C_HEAD_DIM
C_ROT_DIM = C_HEAD_DIM // 4
C_IN = C_HEADS * (4 * C_HEAD_DIM + C_V_DIM)
C_OUT = C_HEADS * C_V_DIM

N_EVEN = (DEPTH + 1) // 2
N_ODD = DEPTH // 2

kernel_name = 'hybrid_streaming_encoder_block'


def rmsnorm(x, g):
    xf = x.astype(jnp.float32)
    y = xf * lax.rsqrt(jnp.mean(xf * xf, axis=-1, keepdims=True) + NORM_EPS)
    return (y * g.astype(jnp.float32)).astype(x.dtype)


def swiglu(h, w_in, w_out):
    a, b = jnp.split(h @ w_in, 2, axis=-1)
    return (jax.nn.silu(a) * b) @ w_out


def rope_tables(seq, rot_dim, dtype):
    inv = ROPE_THETA ** (-jnp.arange(0, rot_dim, 2, dtype=jnp.float32) / rot_dim)
    ang = jnp.arange(seq, dtype=jnp.float32)[:, None] * inv[None, :]
    return jnp.cos(ang).astype(dtype), jnp.sin(ang).astype(dtype)


def apply_rope(x, cos, sin):
    c = cos[None, :, None, :]
    s = sin[None, :, None, :]
    x1, x2 = jnp.split(x, 2, axis=-1)
    return jnp.concatenate([x1 * c - x2 * s, x2 * c + x1 * s], axis=-1)


def partial_rope(x, cos, sin, rot):
    return jnp.concatenate([apply_rope(x[..., :rot], cos, sin), x[..., rot:]], axis=-1)


def chunk_mask(qs, qe, ke):
    qc = jnp.arange(qs, qe) // CHUNK
    kc = jnp.arange(ke) // CHUNK
    return kc[None, :] <= qc[:, None]


def chunked_relpos_attention(q, k, v, rel_table):
    b, s, h, d = q.shape
    nc = s // CHUNK
    band = BAND_CHUNKS * CHUNK
    qc = q.reshape(b, nc, CHUNK, h, d)
    pad = ((0, 0), (N_PREV_CHUNKS, 0), (0, 0), (0, 0), (0, 0))
    kp = jnp.pad(k.reshape(b, nc, CHUNK, h, d), pad)
    vp = jnp.pad(v.reshape(b, nc, CHUNK, h, d), pad)
    idx = jnp.arange(nc)[:, None] + jnp.arange(BAND_CHUNKS)[None, :]
    kb = kp[:, idx].reshape(b, nc, band, h, d)
    vb = vp[:, idx].reshape(b, nc, band, h, d)
    scores = jnp.einsum('bnqhd,bnkhd->bhnqk', qc, kb).astype(jnp.float32) * (d ** -0.5)
    dist = jnp.arange(CHUNK)[:, None] + N_PREV_CHUNKS * CHUNK - jnp.arange(band)[None, :]
    bias = rel_table[:, jnp.clip(dist, -REL_FUTURE, REL_PAST_CLIP) + REL_FUTURE]
    scores = scores + bias[None, :, None].astype(jnp.float32)
    valid = (jnp.arange(nc)[:, None] - N_PREV_CHUNKS + jnp.arange(band)[None, :] // CHUNK) >= 0
    scores = jnp.where(valid[None, None, :, None, :], scores, NEG_INF)
    probs = jax.nn.softmax(scores, axis=-1).astype(v.dtype)
    out = jnp.einsum('bhnqk,bnkhd->bnqhd', probs, vb)
    return out.reshape(b, s, h * d)


def mla_attention(cq, ckv, kr, g_q, w_qup, g_kv, w_kvup, cos, sin):
    b, s, _ = cq.shape
    q = (rmsnorm(cq, g_q) @ w_qup).reshape(b, s, B_HEADS, B_NOPE_DIM + B_ROPE_DIM)
    q_nope = q[..., :B_NOPE_DIM]
    q_rope = apply_rope(q[..., B_NOPE_DIM:], cos, sin)
    kv = (rmsnorm(ckv, g_kv) @ w_kvup).reshape(b, s, B_HEADS, B_NOPE_DIM + B_V_DIM)
    k_nope = kv[..., :B_NOPE_DIM]
    v = kv[..., B_NOPE_DIM:]
    k_rope = apply_rope(kr[:, :, None, :], cos, sin)[:, :, 0, :]
    scale = (B_NOPE_DIM + B_ROPE_DIM) ** -0.5
    outs = []
    for qs in range(0, s, Q_BLOCK):
        qe = qs + Q_BLOCK
        sc = (jnp.einsum('bqhd,bkhd->bhqk', q_nope[:, qs:qe], k_nope[:, :qe])
              + jnp.einsum('bqhr,bkr->bhqk', q_rope[:, qs:qe], k_rope[:, :qe])).astype(jnp.float32) * scale
        sc = jnp.where(chunk_mask(qs, qe, qe)[None, None], sc, NEG_INF)
        pr = jax.nn.softmax(sc, axis=-1).astype(v.dtype)
        outs.append(jnp.einsum('bhqk,bkhd->bqhd', pr, v[:, :qe]))
    return jnp.concatenate(outs, axis=1).reshape(b, s, B_WIDTH)


def diff_attention(u, lq1, lk1, lq2, lk2, g_sub, lambda_init, cos, sin):
    b, s, _ = u.shape
    u = u.reshape(b, s, C_HEADS, 4 * C_HEAD_DIM + C_V_DIM)
    q1, q2, k1, k2 = [partial_rope(u[..., i * C_HEAD_DIM:(i + 1) * C_HEAD_DIM], cos, sin, C_ROT_DIM)
                      for i in range(4)]
    v = u[..., 4 * C_HEAD_DIM:]
    lam = (jnp.exp(jnp.sum(lq1.astype(jnp.float32) * lk1.astype(jnp.float32)))
           - jnp.exp(jnp.sum(lq2.astype(jnp.float32) * lk2.astype(jnp.float32))) + lambda_init)
    scale = C_HEAD_DIM ** -0.5
    outs = []
    for qs in range(0, s, Q_BLOCK):
        qe = qs + Q_BLOCK
        mask = chunk_mask(qs, qe, qe)[None, None]
        s1 = jnp.einsum('bqhd,bkhd->bhqk', q1[:, qs:qe], k1[:, :qe]).astype(jnp.float32) * scale
        s2 = jnp.einsum('bqhd,bkhd->bhqk', q2[:, qs:qe], k2[:, :qe]).astype(jnp.float32) * scale
        w = (jax.nn.softmax(jnp.where(mask, s1, NEG_INF), axis=-1)
             - lam * jax.nn.softmax(jnp.where(mask, s2, NEG_INF), axis=-1))
        outs.append(jnp.einsum('bhqk,bkhd->bqhd', w.astype(v.dtype), v[:, :qe]))
    o = jnp.concatenate(outs, axis=1)
    o = rmsnorm(o, g_sub) * (1.0 - lambda_init)
    return o.reshape(b, s, C_OUT)


def setup_inputs(seed: int = 0) -> dict:
    key = jax.random.key(seed)
    ks = iter(jax.random.split(key, 40))
    f32 = jnp.float32

    def w(shape, fan_in):
        return jax.random.normal(next(ks), shape, f32) * (fan_in ** -0.5)

    def gain(shape):
        return 1.0 + 0.05 * jax.random.normal(next(ks), shape, f32)

    def small(shape, sd):
        return sd * jax.random.normal(next(ks), shape, f32)

    return {
        'x': jax.random.normal(next(ks), (BATCH, SEQ, D_MODEL), f32),
        'p': jax.random.normal(next(ks), (DEPTH, BATCH, SEQ, PLE_DIM), f32),
        'ffn1_g_pre': gain((DEPTH, D_MODEL)),
        'ffn1_w_in': w((DEPTH, D_MODEL, 2 * D_FF), D_MODEL),
        'ffn1_w_out': w((DEPTH, D_FF, D_MODEL), D_FF),
        'ffn1_g_post': gain((DEPTH, D_MODEL)),
        'mix_g_pre': gain((DEPTH, D_MODEL)),
        'mix_g_post': gain((DEPTH, D_MODEL)),
        'ab_w_in': w((N_EVEN, D_MODEL, AB_IN), D_MODEL),
        'a_rel_bias': small((N_EVEN, A_HEADS, REL_TABLE), 0.2),
        'b_g_q': gain((N_EVEN, B_Q_LORA)),
        'b_w_qup': w((N_EVEN, B_Q_LORA, B_HEADS * (B_NOPE_DIM + B_ROPE_DIM)), B_Q_LORA),
        'b_g_kv': gain((N_EVEN, B_KV_LORA)),
        'b_w_kvup': w((N_EVEN, B_KV_LORA, B_HEADS * (B_NOPE_DIM + B_V_DIM)), B_KV_LORA),
        'ab_w_out': w((N_EVEN, AB_OUT, D_MODEL), AB_OUT),
        'c_w_in': w((N_ODD, D_MODEL, C_IN), D_MODEL),
        'c_lq1': small((N_ODD, C_HEAD_DIM), 0.1),
        'c_lk1': small((N_ODD, C_HEAD_DIM), 0.1),
        'c_lq2': small((N_ODD, C_HEAD_DIM), 0.1),
        'c_lk2': small((N_ODD, C_HEAD_DIM), 0.1),
        'c_g_sub': gain((N_ODD, C_V_DIM)),
        'c_w_out': w((N_ODD, C_OUT, D_MODEL), C_OUT),
        'ffn2_g_pre': gain((DEPTH, D_MODEL)),
        'ffn2_w_in': w((DEPTH, D_MODEL, 2 * D_FF), D_MODEL),
        'ffn2_w_out': w((DEPTH, D_FF, D_MODEL), D_FF),
        'ffn2_g_post': gain((DEPTH, D_MODEL)),
        'ple_g_pre': gain((DEPTH, D_MODEL)),
        'ple_w_gate': w((DEPTH, D_MODEL, D_MODEL), D_MODEL),
        'ple_w_proj': w((DEPTH, PLE_DIM, D_MODEL), PLE_DIM),
        'ple_g_post': gain((DEPTH, D_MODEL)),
    }


def reference(x, p, ffn1_g_pre, ffn1_w_in, ffn1_w_out, ffn1_g_post, mix_g_pre, mix_g_post,
              ab_w_in, a_rel_bias, b_g_q, b_w_qup, b_g_kv, b_w_kvup, ab_w_out,
              c_w_in, c_lq1, c_lk1, c_lq2, c_lk2, c_g_sub, c_w_out,
              ffn2_g_pre, ffn2_w_in, ffn2_w_out, ffn2_g_post,
              ple_g_pre, ple_w_gate, ple_w_proj, ple_g_post):
    b, s, _ = x.shape
    cos_b, sin_b = rope_tables(s, B_ROPE_DIM, x.dtype)
    cos_c, sin_c = rope_tables(s, C_ROT_DIM, x.dtype)
    split_at = [A_WIDTH, 2 * A_WIDTH, 3 * A_WIDTH, 3 * A_WIDTH + B_Q_LORA,
                3 * A_WIDTH + B_Q_LORA + B_KV_LORA]
    h = x
    for i in range(DEPTH):
        j = i // 2
        h = h + 0.5 * rmsnorm(swiglu(rmsnorm(h, ffn1_g_pre[i]), ffn1_w_in[i], ffn1_w_out[i]), ffn1_g_post[i])
        hn = rmsnorm(h, mix_g_pre[i])
        if i % 2 == 0:
            u = hn @ ab_w_in[j]
            qa, ka, va, cq, ckv, kr = jnp.split(u, split_at, axis=-1)
            oa = chunked_relpos_attention(qa.reshape(b, s, A_HEADS, A_HEAD_DIM),
                                          ka.reshape(b, s, A_HEADS, A_HEAD_DIM),
                                          va.reshape(b, s, A_HEADS, A_HEAD_DIM), a_rel_bias[j])
            ob = mla_attention(cq, ckv, kr, b_g_q[j], b_w_qup[j], b_g_kv[j], b_w_kvup[j], cos_b, sin_b)
            mix = jnp.concatenate([oa, ob], axis=-1) @ ab_w_out[j]
        else:
            lambda_init = 0.8 - 0.6 * math.exp(-0.3 * i)
            oc = diff_attention(hn @ c_w_in[j], c_lq1[j], c_lk1[j], c_lq2[j], c_lk2[j], c_g_sub[j],
                                lambda_init, cos_c, sin_c)
            mix = oc @ c_w_out[j]
        h = h + rmsnorm(mix, mix_g_post[i])
        h = h + 0.5 * rmsnorm(swiglu(rmsnorm(h, ffn2_g_pre[i]), ffn2_w_in[i], ffn2_w_out[i]), ffn2_g_post[i])
        gate = jax.nn.sigmoid(rmsnorm(h, ple_g_pre[i]) @ ple_w_gate[i])
        h = h + rmsnorm(gate * (p[i] @ ple_w_proj[i]), ple_g_post[i])
    return h
```

```cpp
#include <hip/hip_runtime.h>
#include <hip/hip_bf16.h>
#include <cstdio>
#include <cstdint>
#include <cmath>
namespace pg8 {
#define PG8_LAS __attribute__((address_space(3)))
typedef unsigned short bf16_t;
typedef short bf16x8 __attribute__((ext_vector_type(8)));
typedef float f32x4 __attribute__((ext_vector_type(4)));
typedef unsigned u32x4 __attribute__((ext_vector_type(4)));
constexpr int BM = 256, BK = 64, HALF = 128, HTB = HALF * BK * 2  , STAGE_BYTES = 8 * HTB, NXCD = 8, WGM = 8;

__host__ __device__ __forceinline__ int lds_byte(int r, int c) { const int st = (r >> 4) * 2 + (c >> 5), rr = r & 15, cc = c & 31, ob = rr * 64 + cc * 2; return st * 1024 + (ob ^ (((ob >> 9) & 1) << 5)); }
__host__ __device__ __forceinline__ void stage_rc(int b, int& R, int& C) { const int st = b / 1024, sb = b % 1024, swz = sb ^ (((sb >> 9) & 1) << 5); R = (st >> 1) * 16 + swz / 64; C = (st & 1) * 32 + (swz % 64) / 2; }
__host__ __device__ __forceinline__ int perm32(int rho) { const int n = rho >> 4, i = rho & 15; return 8 * (i >> 2) + 4 * n + (i & 3); }

struct Unit { int pm, pn; };
struct Gemm { const bf16_t* A; const bf16_t* Bt; int M, N, K, lda; };

struct StaticOrder {
    int nM, nN, nwg, G, c;
    __host__ __device__ void init(int M, int N, int G_, int c_) { nM = M / BM; nN = N / BM; nwg = nM * nN; G = G_; c = c_; }
    __host__ __device__ bool next(int i, Unit& u) const {
        const long L = (long)i * G + c; if (L >= nwg) return false;
        int wgid = (int)L; { const int q = nwg / NXCD, r = nwg % NXCD, xcd = wgid % NXCD, off = wgid / NXCD; wgid = (xcd < r ? xcd * (q + 1) : r * (q + 1) + (xcd - r) * q) + off; }
        const int nig = WGM * nN, gid = wgid / nig, fm = gid * WGM, gsz = (nM - fm) < WGM ? (nM - fm) : WGM;
        u.pm = fm + ((wgid % nig) % gsz); u.pn = (wgid % nig) / gsz; return true;
    }
    __device__ __forceinline__ void a_ready(const Unit&) const {}
    __device__ __forceinline__ void done(const Unit&) const {}
};

__device__ __forceinline__ unsigned cvt_pk_bf16(float lo, float hi) { unsigned r; asm volatile("v_cvt_pk_bf16_f32 %0, %1, %2" : "=v"(r) : "v"(lo), "v"(hi)); return r; }
typedef float f32x2 __attribute__((ext_vector_type(2)));

constexpr int SEQ_LEN = 2048;
__device__ __forceinline__ float fast_sigmoid(float x) { return __builtin_amdgcn_rcpf(1.0f + __builtin_amdgcn_exp2f(-1.4426950408889634f * x)); }
__device__ __forceinline__ void rope8(f32x4& v0, f32x4& v1, const float* cosT, const float* sinT, int pos, int half, int i0) {
    const f32x4 c = *(const f32x4*)(cosT + (size_t)pos * half + i0), s = *(const f32x4*)(sinT + (size_t)pos * half + i0);
    float a, b;
    a = v0[0]; b = v0[1]; v0[0] = a * c[0] - b * s[0]; v0[1] = b * c[0] + a * s[0];
    a = v0[2]; b = v0[3]; v0[2] = a * c[1] - b * s[1]; v0[3] = b * c[1] + a * s[1];
    a = v1[0]; b = v1[1]; v1[0] = a * c[2] - b * s[2]; v1[1] = b * c[2] + a * s[2];
    a = v1[2]; b = v1[3]; v1[2] = a * c[3] - b * s[3]; v1[3] = b * c[3] + a * s[3];
}
__device__ __forceinline__ void store8_bf16(bf16_t* p, const f32x4& v0, const f32x4& v1) {
    u32x4 w; w.x = cvt_pk_bf16(v0[0], v0[1]); w.y = cvt_pk_bf16(v0[2], v0[3]); w.z = cvt_pk_bf16(v1[0], v1[1]); w.w = cvt_pk_bf16(v1[2], v1[3]); *(u32x4*)p = w;
}
struct EpiF32 {
    static constexpr bool PERM = false, AFTER_DRAIN = false;
    float* C; int ldc;
    __device__ __forceinline__ void operator()(const f32x4 (&acc)[2][2][4][2], const Unit& u, int wr, int wc, int fr, int fq) const {
        const int row0 = u.pm * BM + wr * 64 + fr, col0 = u.pn * BM + wc * 32 + 4 * fq;
#pragma unroll
        for (int ai = 0; ai < 2; ++ai)
#pragma unroll
            for (int m = 0; m < 4; ++m) { float* rowp = C + (size_t)(row0 + ai * HALF + m * 16) * ldc + col0;
#pragma unroll
                for (int bj = 0; bj < 2; ++bj)
#pragma unroll
                    for (int n = 0; n < 2; ++n) *(f32x4*)(rowp + bj * HALF + n * 16) = acc[ai][bj][m][n]; }
    }
};
struct EpiGate {
    static constexpr bool PERM = false, AFTER_DRAIN = false;
    float* C; const float* PP; int ldc;
    __device__ __forceinline__ void operator()(const f32x4 (&acc)[2][2][4][2], const Unit& u, int wr, int wc, int fr, int fq) const {
        const int row0 = u.pm * BM + wr * 64 + fr, col0 = u.pn * BM + wc * 32 + 4 * fq;
#pragma unroll
        for (int ai = 0; ai < 2; ++ai)
#pragma unroll
            for (int m = 0; m < 4; ++m) { const size_t off = (size_t)(row0 + ai * HALF + m * 16) * ldc + col0;
#pragma unroll
                for (int bj = 0; bj < 2; ++bj)
#pragma unroll
                    for (int n = 0; n < 2; ++n) { const f32x4 pp = *(const f32x4*)(PP + off + bj * HALF + n * 16); const f32x4 a = acc[ai][bj][m][n]; f32x4 o;
                        o[0] = fast_sigmoid(a[0]) * pp[0]; o[1] = fast_sigmoid(a[1]) * pp[1]; o[2] = fast_sigmoid(a[2]) * pp[2]; o[3] = fast_sigmoid(a[3]) * pp[3];
                        *(f32x4*)(C + off + bj * HALF + n * 16) = o; } }
    }
};
struct EpiSwiglu {
    static constexpr bool PERM = true, AFTER_DRAIN = false;
    bf16_t* O; int ldc;
    __device__ __forceinline__ void operator()(const f32x4 (&acc)[2][2][4][2], const Unit& u, int wr, int wc, int fr, int fq) const {
        const int row0 = u.pm * BM + wr * 64 + fr, col0 = u.pn * HALF + wc * 32 + 8 * fq;
#pragma unroll
        for (int ai = 0; ai < 2; ++ai)
#pragma unroll
            for (int m = 0; m < 4; ++m) { bf16_t* p = O + (size_t)(row0 + ai * HALF + m * 16) * ldc + col0;
                f32x4 v0, v1; const f32x4 a0 = acc[ai][0][m][0], a1 = acc[ai][0][m][1], b0 = acc[ai][1][m][0], b1 = acc[ai][1][m][1];
#pragma unroll
                for (int e = 0; e < 4; ++e) { v0[e] = a0[e] * fast_sigmoid(a0[e]) * b0[e]; v1[e] = a1[e] * fast_sigmoid(a1[e]) * b1[e]; }
                store8_bf16(p, v0, v1); }
    }
};
template <int KIND> struct EpiBf {
    static constexpr bool PERM = true, AFTER_DRAIN = false;
    bf16_t* O; int ldc; float* ssq; const float* cosT; const float* sinT; float eps;
    __device__ __forceinline__ void operator()(const f32x4 (&acc)[2][2][4][2], const Unit& u, int wr, int wc, int fr, int fq) const {
        const int row0 = u.pm * BM + wr * 64 + fr, col0 = u.pn * BM + wc * 32 + 8 * fq;
#pragma unroll
        for (int ai = 0; ai < 2; ++ai)
#pragma unroll
            for (int m = 0; m < 4; ++m) {
                const int row = row0 + ai * HALF + m * 16, pos = row & (SEQ_LEN - 1);
                bf16_t* p = O + (size_t)row * ldc + col0;
                float rs = 1.f;
                if (KIND == 1) { const f32x4 s0 = *(const f32x4*)(ssq + (size_t)row * 12), s1 = *(const f32x4*)(ssq + (size_t)row * 12 + 4);
                    rs = 1.0f / sqrtf(((s0[0] + s0[1]) + (s0[2] + s0[3]) + (s1[0] + s1[1]) + (s1[2] + s1[3])) * (1.0f / 512.0f) + eps); }
                if (KIND == 2) { const f32x4 s0 = *(const f32x4*)(ssq + (size_t)row * 12 + 8);
                    rs = 1.0f / sqrtf(((s0[0] + s0[1]) + (s0[2] + s0[3])) * (1.0f / 256.0f) + eps); }
                float sq = 0.f;
#pragma unroll
                for (int bj = 0; bj < 2; ++bj) {
                    f32x4 v0 = acc[ai][bj][m][0] * rs, v1 = acc[ai][bj][m][1] * rs;
                    if (KIND == 0) {
                        if (u.pn == 15 && bj == 0 && wc < 2) rope8(v0, v1, cosT, sinT, pos, 32, wc * 16 + 4 * fq);
                        sq += (v0[0] * v0[0] + v0[1] * v0[1]) + (v0[2] * v0[2] + v0[3] * v0[3]) + (v1[0] * v1[0] + v1[1] * v1[1]) + (v1[2] * v1[2] + v1[3] * v1[3]);
                    }
                    if (KIND == 1) { if (u.pn >= 4) rope8(v0, v1, cosT, sinT, pos, 32, (wc & 1) * 16 + 4 * fq); }
                    if (KIND == 3) { if ((u.pn % 3) != 2 && wc == 0) rope8(v0, v1, cosT, sinT, pos, 16, 4 * fq); }
                    store8_bf16(p + bj * HALF, v0, v1);
                }
                if (KIND == 0) {
                    if (u.pn >= 12 && u.pn <= 14) {
                        sq += __shfl_xor(sq, 16); sq += __shfl_xor(sq, 32);
                        if (fq == 0) ssq[(size_t)row * 12 + (u.pn - 12) * 4 + wc] = sq;
                    }
                }
            }
    }
};
template <class Epi, class Sched, bool ALIGN_EPI = false, bool SP2 = false>
__device__ __forceinline__ void gemm_phase(PG8_LAS unsigned char* lds, const Gemm g, const Sched& S, const Epi& E) {
    int tid_ = threadIdx.x; asm volatile("" : "+v"(tid_));
    const int tid = tid_, wid = __builtin_amdgcn_readfirstlane(tid >> 6), lane = tid & 63, wr = wid >> 2, wc = wid & 3, fr = lane & 15, fq = lane >> 4;
    const int K = g.K, nt = K / BK;
    unsigned voffA[2], voffB[2];
#pragma unroll
    for (int i = 0; i < 2; ++i) { int R, C; stage_rc(tid * 16 + i * 8192, R, C); const int Rb = Epi::PERM ? ((R & ~31) + perm32(R & 31)) : R;
        voffA[i] = (unsigned)(R * g.lda + C) * 2u; voffB[i] = (unsigned)(Rb * K + C) * 2u; }
    const size_t kstep = (size_t)(BK * 2);
    const size_t hstep = (size_t)HALF * K * 2;
    const size_t hstepA = (size_t)HALF * g.lda * 2, tstepA = 2 * hstepA;
    const size_t tstep = 2 * hstep;
    const unsigned ldsw = (unsigned)wid * 1024u;
    const int aoff = lds_byte(wr * 64 + fr, fq * 8), boff = lds_byte(wc * 32 + fr, fq * 8);
#define PG8_SA(b, h) (((b) * 2 + (h)) * HTB)
#define PG8_SB(b, h) ((4 + (b) * 2 + (h)) * HTB)
#define PG8_STAGE(bufoff, gbase, voff) do { _Pragma("unroll") for (int _i = 0; _i < 2; ++_i) \
        __builtin_amdgcn_global_load_lds((const unsigned*)((const char*)(gbase) + (voff)[_i]), (PG8_LAS unsigned*)(lds + (bufoff) + ldsw + _i * 8192), 16, 0, 0); } while (0)
#define PG8_LDA(dst, b, h) do { _Pragma("unroll") for (int m = 0; m < 4; ++m) _Pragma("unroll") for (int k = 0; k < 2; ++k) dst[m][k] = *(const PG8_LAS bf16x8*)(lds + PG8_SA(b, h) + aoff + m * 2048 + k * 1024); } while (0)
#define PG8_LDB(dst, b, h) do { _Pragma("unroll") for (int n = 0; n < 2; ++n) _Pragma("unroll") for (int k = 0; k < 2; ++k) dst[n][k] = *(const PG8_LAS bf16x8*)(lds + PG8_SB(b, h) + boff + n * 2048 + k * 1024); } while (0)
#define PG8_MMA(ai, bj, At, Bt) do { __builtin_amdgcn_s_setprio(1); _Pragma("unroll") for (int m = 0; m < 4; ++m) _Pragma("unroll") for (int n = 0; n < 2; ++n) _Pragma("unroll") for (int k = 0; k < 2; ++k) \
        acc[ai][bj][m][n] = __builtin_amdgcn_mfma_f32_16x16x32_bf16(Bt[n][k], At[m][k], acc[ai][bj][m][n], 0, 0, 0); __builtin_amdgcn_s_setprio(0); } while (0)
#define PG8_WAIT_V(n) asm volatile("s_waitcnt vmcnt(" #n ")" ::: "memory")
#define PG8_WAIT_L(n) asm volatile("s_waitcnt lgkmcnt(" #n ")" ::: "memory")
#define PG8_BAR __builtin_amdgcn_s_barrier()
#define PG8_SCHED __builtin_amdgcn_sched_barrier(0)
    Unit cur, nxt; int ui = 0;
    if (!S.next(0, cur)) return;
    f32x4 acc[2][2][4][2];
#pragma unroll
    for (int a = 0; a < 2; ++a)
#pragma unroll
        for (int b = 0; b < 2; ++b)
#pragma unroll
            for (int m = 0; m < 4; ++m)
#pragma unroll
                for (int n = 0; n < 2; ++n) acc[a][b][m][n] = (f32x4){0.f, 0.f, 0.f, 0.f};
    bf16x8 At[4][2], B0[2][2], B1[2][2];
    const char* cA = (const char*)g.A + (size_t)cur.pm * tstepA; const char* cB = (const char*)g.Bt + (size_t)cur.pn * tstep;
    S.a_ready(cur);
    if constexpr (SP2) {
        PG8_STAGE(PG8_SB(0, 0), cB, voffB); PG8_STAGE(PG8_SB(0, 1), cB + hstep, voffB); PG8_STAGE(PG8_SA(0, 0), cA, voffA); PG8_STAGE(PG8_SA(0, 1), cA + hstepA, voffA);
        if (wr == 1) PG8_BAR;
        PG8_WAIT_V(2); PG8_BAR;
        PG8_STAGE(PG8_SB(1, 0), cB + kstep, voffB); PG8_STAGE(PG8_SA(1, 0), cA + kstep, voffA); PG8_STAGE(PG8_SB(1, 1), cB + hstep + kstep, voffB);
        PG8_WAIT_V(6); PG8_BAR;
    } else {
        PG8_STAGE(PG8_SB(0, 0), cB, voffB); PG8_STAGE(PG8_SA(0, 0), cA, voffA); PG8_STAGE(PG8_SB(0, 1), cB + hstep, voffB); PG8_STAGE(PG8_SA(0, 1), cA + hstepA, voffA);
        if (wr == 1) PG8_BAR;
        PG8_WAIT_V(4); PG8_BAR;
        PG8_STAGE(PG8_SB(1, 0), cB + kstep, voffB); PG8_STAGE(PG8_SA(1, 0), cA + kstep, voffA); PG8_STAGE(PG8_SB(1, 1), cB + hstep + kstep, voffB);
        PG8_WAIT_V(6); PG8_BAR;
    }
    for (;;) {
        const bool has_next = S.next(ui + 1, nxt);
        const char* nA = has_next ? (const char*)g.A + (size_t)nxt.pm * tstepA : cA; const char* nB = has_next ? (const char*)g.Bt + (size_t)nxt.pn * tstep : cB;
        for (int t = 0; t < nt; t += 2) {
            const bool last = (t == nt - 2);
            const char* a1 = cA + (size_t)(t + 1) * kstep;
            const char* a2 = last ? nA : cA + (size_t)(t + 2) * kstep; const char* b2 = last ? nB : cB + (size_t)(t + 2) * kstep;
            const char* a3 = a2 + kstep; const char* b3 = b2 + kstep;
            if (last && has_next) S.a_ready(nxt);
            if constexpr (SP2) {
            PG8_LDB(B0, 0, 0); PG8_LDB(B1, 0, 1); PG8_SCHED; PG8_LDA(At, 0, 0); PG8_STAGE(PG8_SA(1, 1), a1 + hstepA, voffA);
            PG8_WAIT_V(8); PG8_WAIT_L(0); PG8_BAR; PG8_MMA(0, 0, At, B0); PG8_MMA(0, 1, At, B1); PG8_BAR; PG8_SCHED;
            PG8_LDA(At, 0, 1); PG8_STAGE(PG8_SB(0, 0), b2, voffB); PG8_STAGE(PG8_SB(0, 1), b2 + hstep, voffB); PG8_STAGE(PG8_SA(0, 0), a2, voffA);
            PG8_WAIT_V(8); PG8_WAIT_L(0); PG8_BAR; PG8_MMA(1, 0, At, B0); PG8_MMA(1, 1, At, B1); PG8_BAR; PG8_SCHED;
            PG8_LDB(B0, 1, 0); PG8_LDB(B1, 1, 1); PG8_SCHED; PG8_LDA(At, 1, 0); PG8_STAGE(PG8_SA(0, 1), a2 + hstepA, voffA);
            PG8_WAIT_V(8); PG8_WAIT_L(0); PG8_BAR; PG8_MMA(0, 0, At, B0); PG8_MMA(0, 1, At, B1); PG8_BAR; PG8_SCHED;
            PG8_LDA(At, 1, 1); PG8_STAGE(PG8_SB(1, 0), b3, voffB); PG8_STAGE(PG8_SB(1, 1), b3 + hstep, voffB); PG8_STAGE(PG8_SA(1, 0), a3, voffA);
            PG8_WAIT_V(8); PG8_WAIT_L(0); PG8_BAR; PG8_MMA(1, 0, At, B0); PG8_MMA(1, 1, At, B1); PG8_BAR; PG8_SCHED;
            } else {
            PG8_LDB(B0, 0, 0); PG8_SCHED; PG8_LDA(At, 0, 0); PG8_STAGE(PG8_SA(1, 1), a1 + hstepA, voffA);
            PG8_WAIT_L(8); PG8_BAR; PG8_WAIT_L(0); PG8_MMA(0, 0, At, B0); PG8_BAR; PG8_SCHED;
            PG8_LDB(B1, 0, 1); PG8_STAGE(PG8_SB(0, 0), b2, voffB);
            PG8_BAR; PG8_WAIT_L(0); PG8_MMA(0, 1, At, B1); PG8_BAR;
            PG8_LDA(At, 0, 1); PG8_STAGE(PG8_SA(0, 0), a2, voffA);
            PG8_BAR; PG8_WAIT_L(0); PG8_MMA(1, 0, At, B0); PG8_BAR; PG8_SCHED;
            PG8_STAGE(PG8_SB(0, 1), b2 + hstep, voffB);
            PG8_WAIT_V(6); PG8_BAR; PG8_MMA(1, 1, At, B1); PG8_BAR;
            PG8_LDB(B0, 1, 0); PG8_SCHED; PG8_LDA(At, 1, 0); PG8_STAGE(PG8_SA(0, 1), a2 + hstepA, voffA);
            PG8_WAIT_L(8); PG8_BAR; PG8_WAIT_L(0); PG8_MMA(0, 0, At, B0); PG8_BAR; PG8_SCHED;
            PG8_LDB(B1, 1, 1); PG8_STAGE(PG8_SB(1, 0), b3, voffB);
            PG8_BAR; PG8_WAIT_L(0); PG8_MMA(0, 1, At, B1); PG8_BAR;
            PG8_LDA(At, 1, 1); PG8_STAGE(PG8_SA(1, 0), a3, voffA);
            PG8_BAR; PG8_WAIT_L(0); PG8_MMA(1, 0, At, B0); PG8_BAR; PG8_SCHED;
            PG8_STAGE(PG8_SB(1, 1), b3 + hstep, voffB);
            PG8_WAIT_V(6); PG8_BAR; PG8_MMA(1, 1, At, B1); PG8_BAR;
            }
        }
        if constexpr (ALIGN_EPI) { if (wr == 0) PG8_BAR; }
        if constexpr (!Epi::AFTER_DRAIN) { E(acc, cur, wr, wc, fr, fq); S.done(cur); }
        if (!has_next) break;
#pragma unroll
        for (int a = 0; a < 2; ++a)
#pragma unroll
            for (int b = 0; b < 2; ++b)
#pragma unroll
                for (int m = 0; m < 4; ++m)
#pragma unroll
                    for (int n = 0; n < 2; ++n) acc[a][b][m][n] = (f32x4){0.f, 0.f, 0.f, 0.f};
        cur = nxt; cA = nA; cB = nB; ++ui;
        if constexpr (ALIGN_EPI) { if (wr == 1) PG8_BAR; }
    }
    PG8_WAIT_V(0);
    if constexpr (!ALIGN_EPI) { if (wr == 0) PG8_BAR; }
    PG8_BAR;
    if constexpr (Epi::AFTER_DRAIN) { E.fused(acc, cur, wr, wc, fr, fq, lds, wid, lane); S.done(cur); }
#undef PG8_SA
#undef PG8_SB
#undef PG8_STAGE
#undef PG8_LDA
#undef PG8_LDB
#undef PG8_MMA
#undef PG8_WAIT_V
#undef PG8_WAIT_L
#undef PG8_BAR
#undef PG8_SCHED
}
}
#define GAS __attribute__((address_space(1)))
#define LAS __attribute__((address_space(3)))
typedef unsigned short bf16;
typedef unsigned v4u __attribute__((ext_vector_type(4)));
typedef float f32x4 __attribute__((ext_vector_type(4)));
typedef short bf16x8 __attribute__((ext_vector_type(8)));
typedef GAS unsigned gu32;
typedef GAS unsigned long long gu64;
#define RLX_AGENT __ATOMIC_RELAXED, __HIP_MEMORY_SCOPE_AGENT
#define LDS_WAIT() asm volatile("s_waitcnt lgkmcnt(0)" ::: "memory")
#define VM_WAIT() asm volatile("s_waitcnt vmcnt(0)" ::: "memory")
__device__ __forceinline__ unsigned long long rt() { return __builtin_amdgcn_s_memrealtime(); }
__device__ __forceinline__ unsigned f2bf(float f) { unsigned u = __builtin_bit_cast(unsigned, f); return (u + 0x7fffu + ((u >> 16) & 1u)) >> 16; }
__device__ __forceinline__ unsigned pk2(float lo, float hi) { return f2bf(lo) | (f2bf(hi) << 16); }

#define XB_TMO      128
#define XB_XCNT(j)  (256  + 64 * (j))
#define XB_XSUB(j)  (1280 + 64 * (j))
#define XB_XGEN(j)  (2304 + 64 * (j))
#define XB_TOP      3328
#define XB_TOPGEN   3392
#define XCD_BAR_WORDS 3456
#define XB_SPIN_CAP (1u << 18)

__device__ __forceinline__ unsigned xb_ld(unsigned* p)              { return __hip_atomic_load(p, __ATOMIC_RELAXED, __HIP_MEMORY_SCOPE_AGENT); }
__device__ __forceinline__ unsigned xb_add(unsigned* p, unsigned v) { return __hip_atomic_fetch_add(p, v, __ATOMIC_RELAXED, __HIP_MEMORY_SCOPE_AGENT); }
__device__ __forceinline__ unsigned xb_xcc_id() { return (unsigned)__builtin_amdgcn_s_getreg((3 << 11) | 20) & 0xFu; }
#define XB_SPIN(cond, bar) do { unsigned _sp = 0; while (cond) { __builtin_amdgcn_s_sleep(1); \
    if ((++_sp & 255u) == 0u) { if (xb_ld(&(bar)[XB_TMO])) break; if (_sp > XB_SPIN_CAP) { atomicAdd(&(bar)[XB_TMO], 1u); break; } } } } while (0)

struct XcdBarrier {
    unsigned* bar; unsigned x;
    volatile LAS unsigned* st;
};

__device__ __forceinline__ XcdBarrier xcd_barrier_post(unsigned* bar, volatile LAS unsigned* st) {
    XcdBarrier b; b.bar = bar; b.x = xb_xcc_id(); b.st = st;
    if (threadIdx.x == 0) (void)xb_add(&bar[XB_XCNT(b.x)], 1u);
    return b;
}
__device__ __forceinline__ void xcd_barrier_complete(unsigned* bar, unsigned x, unsigned& nloc, unsigned& nx) {
    const unsigned G = gridDim.x * gridDim.y * gridDim.z;
    unsigned sum, cnt, mine, sp = 0u;
    for (;;) {
        sum = 0u; cnt = 0u; mine = 0u;
#pragma unroll
        for (unsigned j = 0; j < 16; ++j) { const unsigned c = xb_ld(&bar[XB_XCNT(j)]); sum += c; cnt += (c > 0u) ? 1u : 0u; mine = (j == x) ? c : mine; }
        if (sum == G) break;
        __builtin_amdgcn_s_sleep(1);
        if ((++sp & 255u) == 0u) { if (xb_ld(&bar[XB_TMO])) break; if (sp > XB_SPIN_CAP) { atomicAdd(&bar[XB_TMO], 1u); break; } }
    }
    nloc = mine > 0u ? mine : 1u; nx = cnt > 0u ? cnt : 1u;
}

__device__ __forceinline__ void xcd_barrier(const XcdBarrier& b) {
    asm volatile("s_waitcnt vmcnt(0)" ::: "memory");
    __syncthreads();
    if (threadIdx.x == 0) {
        unsigned* bar = b.bar;
        __builtin_amdgcn_s_waitcnt(0);
        unsigned nloc = b.st[0], nx = b.st[1];
        if (nloc == 0u) { xcd_barrier_complete(bar, b.x, nloc, nx); b.st[0] = nloc; b.st[1] = nx; }
        const unsigned old = xb_add(&bar[XB_XSUB(b.x)], 1u);
        const unsigned gen = old / nloc;
        if (old + 1u == (gen + 1u) * nloc) {
            __builtin_amdgcn_fence(__ATOMIC_RELEASE, "agent");
            asm volatile("s_waitcnt vmcnt(0)" ::: "memory");
            const unsigned og = xb_add(&bar[XB_TOP], 1u);
            const unsigned tg = og / nx;
            if (og + 1u == (tg + 1u) * nx) xb_add(&bar[XB_TOPGEN], 1u);
            else XB_SPIN(xb_ld(&bar[XB_TOPGEN]) == tg, bar);
            __builtin_amdgcn_fence(__ATOMIC_ACQUIRE, "agent");
            xb_add(&bar[XB_XGEN(b.x)], 1u);
            asm volatile("s_waitcnt vmcnt(0)" ::: "memory");
        } else {
            XB_SPIN(xb_ld(&bar[XB_XGEN(b.x)]) == gen, bar);
            __builtin_amdgcn_fence(__ATOMIC_ACQUIRE, "agent");
            asm volatile("s_waitcnt vmcnt(0)" ::: "memory");
        }
    }
    __syncthreads();
}

constexpr int NWAVES = 8;
constexpr int T = 8192, SEQ = 2048, DM = 2048, FF = 5632, NLAYER = 4, PLE = 256;
constexpr int AB_IN = 3904, AB_INP = 4096, C_IN = 6144, QUP_N = 1536, KVUP_N = 2048;
constexpr float NORM_EPS = 1e-6f;
constexpr size_t MiB = 1u << 20;
constexpr size_t WS_CTL = 0, CTL_ZERO_BYTES = 1 * MiB;
constexpr size_t WS_ROPE = 1 * MiB;
constexpr size_t WS_SSQ = 2 * MiB;
constexpr size_t WS_PB = 4 * MiB;
constexpr size_t WS_W = 20 * MiB;
constexpr size_t W_FFN_IN = WS_W, SZ_FFN_IN = 44 * MiB;
constexpr size_t W_FFN_OUT = W_FFN_IN + 8 * SZ_FFN_IN, SZ_FFN_OUT = 22 * MiB;
constexpr size_t W_AB_IN = W_FFN_OUT + 8 * SZ_FFN_OUT, SZ_AB_IN = 16 * MiB;
constexpr size_t W_QUP = W_AB_IN + 2 * SZ_AB_IN, SZ_QUP = 3 * MiB / 2;
constexpr size_t W_KVUP = W_QUP + 2 * SZ_QUP, SZ_KVUP = 1 * MiB;
constexpr size_t W_AB_OUT = W_KVUP + 2 * SZ_KVUP, SZ_SQ = 8 * MiB;
constexpr size_t W_C_IN = W_AB_OUT + 2 * SZ_SQ, SZ_C_IN = 24 * MiB;
constexpr size_t W_C_OUT = W_C_IN + 2 * SZ_C_IN;
constexpr size_t W_GATE = W_C_OUT + 2 * SZ_SQ;
constexpr size_t W_PROJ = W_GATE + 4 * SZ_SQ, SZ_PROJ = 1 * MiB;
constexpr size_t W_END = W_PROJ + 4 * SZ_PROJ;
constexpr size_t WS_XN = 704 * MiB;
constexpr size_t WS_G = 736 * MiB;
constexpr size_t WS_Y = 824 * MiB;
constexpr size_t WS_U = 888 * MiB;
constexpr size_t WS_QB = 984 * MiB;
constexpr size_t WS_KVB = 1008 * MiB;
constexpr size_t WS_OAT = 1040 * MiB;
constexpr size_t WS_OS = 1072 * MiB;
constexpr size_t WS_PP = 1200 * MiB;
constexpr size_t WS_END = 1264 * MiB;
static_assert(W_END <= WS_XN, "weights overflow");
constexpr int CW_BAR = 4096;

constexpr int RING_OFF = 0, RING_BYTES = 131072;
constexpr int LDSCTL_OFF = RING_BYTES, MISC_OFF = LDSCTL_OFF + 320;
constexpr int LDS_BYTES = 147456;
static_assert(MISC_OFF + 128 <= LDS_BYTES, "LDS map");

struct Frame {
    LAS unsigned char* lds;
    int tid, lane, wave, gw, NGW, G;
};
__device__ __forceinline__ float wave_sum(float v) {
#pragma unroll
    for (int o = 1; o < 64; o <<= 1) v += __shfl_xor(v, o);
    return v;
}
__device__ __forceinline__ int il_pair(int r, int half) { return r < half ? 2 * r : 2 * (r - half) + 1; }
__device__ __forceinline__ int wmap(int kind, int n) {
    switch (kind) {
        case 1: { const int r = n >= FF ? 1 : 0, j = n - r * FF; return (j >> 7) * 256 + r * 128 + (j & 127); }
        case 2: return n < 3840 ? n : 3840 + il_pair(n - 3840, 32);
        case 3: { const int h = n / 192, d = n % 192; return d < 128 ? h * 128 + d : 1024 + h * 64 + il_pair(d - 128, 32); }
        case 4: { const int h = n >> 8, d = n & 255; return d < 128 ? h * 128 + d : 1024 + h * 128 + (d - 128); }
        case 5: { const int h = n / 768, r = n % 768; if (r >= 512) return n; const int part = r >> 7, d = r & 127; return h * 768 + part * 128 + (d < 32 ? il_pair(d, 16) : d); }
        default: return n;
    }
}
__device__ __forceinline__ void transpose_item(const float* W, int K, int N, bf16* WT, int kind, const float* gain, LAS float* scr, int item, int lane) {
    const int nblk = N / 32, kb = item / nblk, nb = item % nblk, k0 = 64 * kb, n0 = 32 * nb;
#pragma unroll 8
    for (int i = 0; i < 32; ++i) { const int kk = 2 * i + (lane >> 5); float w = W[(size_t)(k0 + kk) * N + n0 + (lane & 31)]; if (gain) w *= gain[k0 + kk]; scr[kk * 33 + (lane & 31)] = w; }
    LDS_WAIT(); asm volatile("" ::: "memory");
    const int c = lane & 7;
#pragma unroll
    for (int j = 0; j < 4; ++j) { const int n = (lane >> 3) + 8 * j; const LAS float* s = scr + (8 * c) * 33 + n;
        v4u o; o.x = pk2(s[0 * 33], s[1 * 33]); o.y = pk2(s[2 * 33], s[3 * 33]); o.z = pk2(s[4 * 33], s[5 * 33]); o.w = pk2(s[6 * 33], s[7 * 33]);
        *(GAS v4u*)(WT + (size_t)wmap(kind, n0 + n) * K + k0 + 8 * c) = o; }
    LDS_WAIT(); asm volatile("" ::: "memory");
}
__device__ __forceinline__ void transpose_all(const Frame& F, const float* W, int K, int N, bf16* WT, int kind, const float* gain) {
    LAS float* scr = (LAS float*)(F.lds + RING_OFF + F.wave * 16384);
    const int nitems = (K / 64) * (N / 32);
    for (int it = F.gw; it < nitems; it += F.NGW) transpose_item(W, K, N, WT, kind, gain, scr, it, F.lane);
}
__device__ __forceinline__ void norm_pass(const Frame& F, const float* y, const float* hin, float* hout, const float* g_post, float coef, const float* g_pre, bf16* xn) {
    for (int row = F.gw; row < T; row += F.NGW) {
        const GAS f32x4* hr = (const GAS f32x4*)(hin + (size_t)row * DM) + F.lane;
        f32x4 hv[8];
#pragma unroll
        for (int j = 0; j < 8; ++j) hv[j] = hr[64 * j];
        if (y) {
            const GAS f32x4* yr = (const GAS f32x4*)(y + (size_t)row * DM) + F.lane;
            f32x4 yv[8]; float s = 0.f;
#pragma unroll
            for (int j = 0; j < 8; ++j) { yv[j] = yr[64 * j]; s += (yv[j].x * yv[j].x + yv[j].y * yv[j].y) + (yv[j].z * yv[j].z + yv[j].w * yv[j].w); }
            const float rstd = coef / sqrtf(wave_sum(s) * (1.f / DM) + NORM_EPS);
#pragma unroll
            for (int j = 0; j < 8; ++j) { const f32x4 g = *((const GAS f32x4*)g_post + F.lane + 64 * j); hv[j] = hv[j] + yv[j] * rstd * g; }
        }
        GAS f32x4* ho = (GAS f32x4*)(hout + (size_t)row * DM) + F.lane;
#pragma unroll
        for (int j = 0; j < 8; ++j) ho[64 * j] = hv[j];
        if (g_pre) {
            float s2 = 0.f;
#pragma unroll
            for (int j = 0; j < 8; ++j) s2 += (hv[j].x * hv[j].x + hv[j].y * hv[j].y) + (hv[j].z * hv[j].z + hv[j].w * hv[j].w);
            const float rstd2 = 1.f / sqrtf(wave_sum(s2) * (1.f / DM) + NORM_EPS);
            GAS unsigned long long* o8 = (GAS unsigned long long*)(xn + (size_t)row * DM) + F.lane;
#pragma unroll
            for (int j = 0; j < 8; ++j) { const f32x4 g = *((const GAS f32x4*)g_pre + F.lane + 64 * j); const f32x4 v = hv[j] * rstd2 * g;
                o8[64 * j] = (unsigned long long)pg8::cvt_pk_bf16(v.x, v.y) | ((unsigned long long)pg8::cvt_pk_bf16(v.z, v.w) << 32); }
        }
    }
}

typedef __bf16 bf16x2_t __attribute__((ext_vector_type(2)));
__device__ __forceinline__ float dot2bf(unsigned a, unsigned b, float c) { return __builtin_amdgcn_fdot2_f32_bf16(__builtin_bit_cast(bf16x2_t, a), __builtin_bit_cast(bf16x2_t, b), c, false); }
template <int DQK, bool BIAS, int VC>
__device__ __forceinline__ void sattn_wave(const bf16* qa, const bf16* qb, const bf16* ka, size_t pka, const bf16* kb, size_t pkb, const bf16* v, size_t pv,
                                           int j0, int j1, float sc2, const float* bias2  , int qpos, int kpos0, float (&acc)[VC]) {
    constexpr int NQ = DQK / 2;
    unsigned qp[NQ];
#pragma unroll
    for (int c = 0; c < 16; ++c) { const v4u w = *(const GAS v4u*)(qa + 8 * c); qp[4 * c] = w.x; qp[4 * c + 1] = w.y; qp[4 * c + 2] = w.z; qp[4 * c + 3] = w.w; }
    if constexpr (DQK == 192) {
#pragma unroll
        for (int c = 0; c < 8; ++c) { const v4u w = *(const GAS v4u*)(qb + 8 * c); qp[64 + 4 * c] = w.x; qp[64 + 4 * c + 1] = w.y; qp[64 + 4 * c + 2] = w.z; qp[64 + 4 * c + 3] = w.w; }
    }
#pragma unroll
    for (int c = 0; c < VC; ++c) acc[c] = 0.f;
    float m = -1e30f, l = 0.f;
#pragma unroll 1
    for (int j = j0; j < j1; ++j) {
        const GAS v4u* kr = (const GAS v4u*)(ka + (size_t)j * pka);
        float d0 = 0.f, d1 = 0.f;
#pragma unroll
        for (int c = 0; c < 16; ++c) { const v4u w = kr[c]; d0 = dot2bf(w.x, qp[4 * c], d0); d1 = dot2bf(w.y, qp[4 * c + 1], d1); d0 = dot2bf(w.z, qp[4 * c + 2], d0); d1 = dot2bf(w.w, qp[4 * c + 3], d1); }
        if constexpr (DQK == 192) {
            const GAS v4u* kr2 = (const GAS v4u*)(kb + (size_t)j * pkb);
#pragma unroll
            for (int c = 0; c < 8; ++c) { const v4u w = kr2[c]; d0 = dot2bf(w.x, qp[64 + 4 * c], d0); d1 = dot2bf(w.y, qp[64 + 4 * c + 1], d1); d0 = dot2bf(w.z, qp[64 + 4 * c + 2], d0); d1 = dot2bf(w.w, qp[64 + 4 * c + 3], d1); }
        }
        float sv = (d0 + d1) * sc2;
        if constexpr (BIAS) { int dist = qpos - (kpos0 + (j - j0)); dist = dist < -63 ? -63 : (dist > 128 ? 128 : dist); sv += bias2[dist + 63]; }
        const float mn = fmaxf(m, sv), alpha = __builtin_amdgcn_exp2f(m - mn), pw = __builtin_amdgcn_exp2f(sv - mn);
        m = mn; l = l * alpha + pw;
        const GAS v4u* vr = (const GAS v4u*)(v + (size_t)j * pv);
#pragma unroll
        for (int c = 0; c < VC / 8; ++c) { const v4u w = vr[c];
            acc[8 * c + 0] = acc[8 * c + 0] * alpha + pw * __uint_as_float(w.x << 16); acc[8 * c + 1] = acc[8 * c + 1] * alpha + pw * __uint_as_float(w.x & 0xffff0000u);
            acc[8 * c + 2] = acc[8 * c + 2] * alpha + pw * __uint_as_float(w.y << 16); acc[8 * c + 3] = acc[8 * c + 3] * alpha + pw * __uint_as_float(w.y & 0xffff0000u);
            acc[8 * c + 4] = acc[8 * c + 4] * alpha + pw * __uint_as_float(w.z << 16); acc[8 * c + 5] = acc[8 * c + 5] * alpha + pw * __uint_as_float(w.z & 0xffff0000u);
            acc[8 * c + 6] = acc[8 * c + 6] * alpha + pw * __uint_as_float(w.w << 16); acc[8 * c + 7] = acc[8 * c + 7] * alpha + pw * __uint_as_float(w.w & 0xffff0000u); }
    }
    const float rl = 1.0f / l;
#pragma unroll
    for (int c = 0; c < VC; ++c) acc[c] *= rl;
}
template <int VC> __device__ __forceinline__ void storeN_bf16(bf16* o, const float (&acc)[VC]) {
#pragma unroll
    for (int c = 0; c < VC / 8; ++c) { v4u w; w.x = pg8::cvt_pk_bf16(acc[8 * c], acc[8 * c + 1]); w.y = pg8::cvt_pk_bf16(acc[8 * c + 2], acc[8 * c + 3]); w.z = pg8::cvt_pk_bf16(acc[8 * c + 4], acc[8 * c + 5]); w.w = pg8::cvt_pk_bf16(acc[8 * c + 6], acc[8 * c + 7]);
        *(GAS v4u*)(o + 8 * c) = w; }
}
__device__ __forceinline__ void store64_f32(float* o, const float (&acc)[64]) {
#pragma unroll
    for (int c = 0; c < 16; ++c) *(GAS f32x4*)(o + 4 * c) = (f32x4){acc[4 * c], acc[4 * c + 1], acc[4 * c + 2], acc[4 * c + 3]};
}
constexpr float LOG2E = 1.4426950408889634f;
__device__ __forceinline__ void attn_even_simple(const Frame& F, const bf16* U, const bf16* QB, const bf16* KVB, bf16* OAT, const float* bias2  ) {
    for (int u = F.gw; u < 2048; u += F.NGW) {
        float acc[64];
        const int n = u & 31, r = u >> 5, slice = r & 1, h = (r >> 1) & 7, b = r >> 4;
        const int row = b * SEQ + n * 64 + F.lane, nlo = n >= 8 ? n - 8 : 0;
        sattn_wave<128, true, 64>(U + (size_t)row * AB_INP + h * 128, nullptr, U + 1024 + h * 128, AB_INP, nullptr, 0, U + 2048 + h * 128 + slice * 64, AB_INP,
                                  b * SEQ + nlo * 64, b * SEQ + (n + 1) * 64, 0.08838834764831845f * LOG2E, bias2 + h * 192, n * 64 + F.lane, nlo * 64, acc);
        storeN_bf16<64>(OAT + (size_t)row * DM + h * 128 + slice * 64, acc);
    }
    for (int u = F.gw; u < 4096; u += F.NGW) {
        float acc[32];
        const int k = u >> 11, w = u & 2047, nb = w & 31, n = k ? 31 - nb : nb, r = (w >> 5) + 64 * k, slice = r & 3, h = (r >> 2) & 7, b = r >> 5;
        const int row = b * SEQ + n * 64 + F.lane;
        sattn_wave<192, false, 32>(QB + (size_t)row * QUP_N + h * 128, QB + (size_t)row * QUP_N + 1024 + h * 64, KVB + h * 128, KVUP_N, U + 3840, AB_INP, KVB + 1024 + h * 128 + slice * 32, KVUP_N,
                                   b * SEQ, b * SEQ + (n + 1) * 64, 0.07216878364870322f * LOG2E, nullptr, 0, 0, acc);
        storeN_bf16<32>(OAT + (size_t)row * DM + 1024 + h * 128 + slice * 32, acc);
    }
}
__device__ __forceinline__ void attn_odd_simple(const Frame& F, const bf16* U, float* OS) {
    float acc[64];
    for (int u = F.gw; u < 8192; u += F.NGW) {
        const int k = u >> 11, w = u & 2047, nb = w & 31, n = (k & 1) ? 31 - nb : nb, r = (w >> 5) + 64 * k, slice = r & 3, s = (r >> 2) & 1, h = (r >> 3) & 7, b = r >> 6;
        const int row = b * SEQ + n * 64 + F.lane;
        sattn_wave<128, false, 64>(U + (size_t)row * C_IN + h * 768 + s * 128, nullptr, U + h * 768 + 256 + s * 128, C_IN, nullptr, 0, U + h * 768 + 512 + slice * 64, C_IN,
                               b * SEQ, b * SEQ + (n + 1) * 64, 0.08838834764831845f * LOG2E, nullptr, 0, 0, acc);
        store64_f32(OS + (size_t)s * T * DM + (size_t)row * DM + h * 256 + slice * 64, acc);
    }
}
__device__ __forceinline__ void csub_pass(const Frame& F, const float* OS, bf16* OAT, const float* lq1, const float* lk1, const float* lq2, const float* lk2, const float* g_sub, int layer) {
    asm volatile("" : "+s"(layer));
    const float lambda_init = 0.8f - 0.6f * expf(-0.3f * (float)layer);
    const float d1 = wave_sum(lq1[F.lane] * lk1[F.lane] + lq1[F.lane + 64] * lk1[F.lane + 64]);
    const float d2 = wave_sum(lq2[F.lane] * lk2[F.lane] + lq2[F.lane + 64] * lk2[F.lane + 64]);
    const float lam = expf(d1) - expf(d2) + lambda_init, post = 1.0f - lambda_init;
    const f32x4 g = *((const GAS f32x4*)g_sub + F.lane);
    for (int row = F.gw; row < T; row += F.NGW) {
#pragma unroll
        for (int h = 0; h < 8; ++h) {
            const f32x4 o1 = *((const GAS f32x4*)(OS + (size_t)row * DM + h * 256) + F.lane), o2 = *((const GAS f32x4*)(OS + (size_t)T * DM + (size_t)row * DM + h * 256) + F.lane);
            const f32x4 d = o1 - o2 * lam;
            const float ss = wave_sum((d.x * d.x + d.y * d.y) + (d.z * d.z + d.w * d.w));
            const float rstd = post / sqrtf(ss * (1.f / 256.f) + NORM_EPS);
            const f32x4 o = d * rstd * g;
            *((GAS unsigned long long*)(OAT + (size_t)row * DM + h * 256) + F.lane) = (unsigned long long)pg8::cvt_pk_bf16(o.x, o.y) | ((unsigned long long)pg8::cvt_pk_bf16(o.z, o.w) << 32);
        }
    }
}

struct Args { const float* in[30]; float* out; unsigned char* ws; };
enum { IN_X = 0, IN_P, IN_F1_GPRE, IN_F1_WIN, IN_F1_WOUT, IN_F1_GPOST, IN_MIX_GPRE, IN_MIX_GPOST, IN_AB_WIN, IN_A_BIAS, IN_B_GQ, IN_B_WQUP, IN_B_GKV, IN_B_WKVUP, IN_AB_WOUT,
       IN_C_WIN, IN_C_LQ1, IN_C_LK1, IN_C_LQ2, IN_C_LK2, IN_C_GSUB, IN_C_WOUT, IN_F2_GPRE, IN_F2_WIN, IN_F2_WOUT, IN_F2_GPOST, IN_PLE_GPRE, IN_PLE_WGATE, IN_PLE_WPROJ, IN_PLE_GPOST };

__global__ void __launch_bounds__(NWAVES * 64, 2) fwd_kernel(Args args) {
    extern __shared__ __attribute__((aligned(16))) unsigned char lds[];
    Frame F;
    F.lds = (LAS unsigned char*)lds;
    volatile LAS unsigned* MISC = (volatile LAS unsigned*)(F.lds + MISC_OFF);
    F.tid = threadIdx.x; F.lane = F.tid & 63; F.wave = __builtin_amdgcn_readfirstlane(F.tid >> 6);
    F.G = gridDim.x; F.gw = blockIdx.x * NWAVES + F.wave; F.NGW = F.G * NWAVES;
    unsigned char* ws = args.ws;
    gu32* ctl = (gu32*)(ws + WS_CTL);
    for (int u = F.tid; u < (LDS_BYTES - LDSCTL_OFF) / 4; u += NWAVES * 64) ((LAS unsigned*)(F.lds + LDSCTL_OFF))[u] = 0u;
    __syncthreads();
    XcdBarrier bar = xcd_barrier_post((unsigned*)(ctl + CW_BAR), MISC + 8);
#define GRID_BAR() do { XcdBarrier b_ = bar; asm volatile("" : "+s"(b_.bar), "+s"(b_.x)); xcd_barrier(b_); } while (0)
#define PHASE() do { int t_ = threadIdx.x; asm volatile("" : "+v"(t_)); F.tid = t_; F.lane = t_ & 63; } while (0)

    float* const h = args.out;
    float* cosB = (float*)(ws + WS_ROPE); float* sinB = cosB + 2048 * 32; float* cosC = sinB + 2048 * 32; float* sinC = cosC + 2048 * 16;
    float* bias2 = sinC + 2048 * 16;
    float* SSQ = (float*)(ws + WS_SSQ);
    bf16* PB = (bf16*)(ws + WS_PB);
    bf16* XN = (bf16*)(ws + WS_XN); bf16* Gb = (bf16*)(ws + WS_G); float* Y = (float*)(ws + WS_Y); bf16* U = (bf16*)(ws + WS_U);
    bf16* QB = (bf16*)(ws + WS_QB); bf16* KVB = (bf16*)(ws + WS_KVB); bf16* OAT = (bf16*)(ws + WS_OAT); float* OS = (float*)(ws + WS_OS); float* PP = (float*)(ws + WS_PP);

    {
        PHASE();
        for (int l = 0; l < NLAYER; ++l) {
            transpose_all(F, args.in[IN_F1_WIN] + (size_t)l * DM * 2 * FF, DM, 2 * FF, (bf16*)(ws + W_FFN_IN + (size_t)(0 * 4 + l) * SZ_FFN_IN), 1, nullptr);
            transpose_all(F, args.in[IN_F2_WIN] + (size_t)l * DM * 2 * FF, DM, 2 * FF, (bf16*)(ws + W_FFN_IN + (size_t)(1 * 4 + l) * SZ_FFN_IN), 1, nullptr);
            transpose_all(F, args.in[IN_F1_WOUT] + (size_t)l * FF * DM, FF, DM, (bf16*)(ws + W_FFN_OUT + (size_t)(0 * 4 + l) * SZ_FFN_OUT), 0, nullptr);
            transpose_all(F, args.in[IN_F2_WOUT] + (size_t)l * FF * DM, FF, DM, (bf16*)(ws + W_FFN_OUT + (size_t)(1 * 4 + l) * SZ_FFN_OUT), 0, nullptr);
            transpose_all(F, args.in[IN_PLE_WGATE] + (size_t)l * DM * DM, DM, DM, (bf16*)(ws + W_GATE + (size_t)l * SZ_SQ), 0, nullptr);
            transpose_all(F, args.in[IN_PLE_WPROJ] + (size_t)l * PLE * DM, PLE, DM, (bf16*)(ws + W_PROJ + (size_t)l * SZ_PROJ), 0, nullptr);
        }
        for (int j = 0; j < 2; ++j) {
            transpose_all(F, args.in[IN_AB_WIN] + (size_t)j * DM * AB_IN, DM, AB_IN, (bf16*)(ws + W_AB_IN + (size_t)j * SZ_AB_IN), 2, nullptr);
            transpose_all(F, args.in[IN_B_WQUP] + (size_t)j * 512 * QUP_N, 512, QUP_N, (bf16*)(ws + W_QUP + (size_t)j * SZ_QUP), 3, args.in[IN_B_GQ] + j * 512);
            transpose_all(F, args.in[IN_B_WKVUP] + (size_t)j * 256 * KVUP_N, 256, KVUP_N, (bf16*)(ws + W_KVUP + (size_t)j * SZ_KVUP), 4, args.in[IN_B_GKV] + j * 256);
            transpose_all(F, args.in[IN_AB_WOUT] + (size_t)j * DM * DM, DM, DM, (bf16*)(ws + W_AB_OUT + (size_t)j * SZ_SQ), 0, nullptr);
            transpose_all(F, args.in[IN_C_WIN] + (size_t)j * DM * C_IN, DM, C_IN, (bf16*)(ws + W_C_IN + (size_t)j * SZ_C_IN), 5, nullptr);
            transpose_all(F, args.in[IN_C_WOUT] + (size_t)j * DM * DM, DM, DM, (bf16*)(ws + W_C_OUT + (size_t)j * SZ_SQ), 0, nullptr);
            { GAS v4u* z = (GAS v4u*)(ws + W_AB_IN + (size_t)j * SZ_AB_IN + (size_t)AB_IN * DM * 2); const int nz = (AB_INP - AB_IN) * DM * 2 / 16;
              for (int i = blockIdx.x * (NWAVES * 64) + F.tid; i < nz; i += F.G * NWAVES * 64) z[i] = (v4u){0u, 0u, 0u, 0u}; }
        }
        for (int i = blockIdx.x * (NWAVES * 64) + F.tid; i < 2048 * 32; i += F.G * NWAVES * 64) { const int pos = i >> 5, f = i & 31; const float inv = powf(500000.0f, -(float)(2 * f) / 64.0f), ang = (float)pos * inv; cosB[i] = cosf(ang); sinB[i] = sinf(ang); }
        for (int i = blockIdx.x * (NWAVES * 64) + F.tid; i < 2048 * 16; i += F.G * NWAVES * 64) { const int pos = i >> 4, f = i & 15; const float inv = powf(500000.0f, -(float)(2 * f) / 32.0f), ang = (float)pos * inv; cosC[i] = cosf(ang); sinC[i] = sinf(ang); }
        { const GAS f32x4* src = (const GAS f32x4*)args.in[IN_P]; GAS unsigned long long* dst = (GAS unsigned long long*)PB; const int n4 = NLAYER * T * PLE / 4;
          for (int i = blockIdx.x * (NWAVES * 64) + F.tid; i < n4; i += F.G * NWAVES * 64) { const f32x4 v = src[i]; dst[i] = (unsigned long long)pg8::cvt_pk_bf16(v.x, v.y) | ((unsigned long long)pg8::cvt_pk_bf16(v.z, v.w) << 32); } }
        norm_pass(F, nullptr, args.in[IN_X], h, nullptr, 0.f, args.in[IN_F1_GPRE], XN);
    }
    GRID_BAR();

    for (int i = 0; i < NLAYER; ++i) {
        const int j = i >> 1; const bool even = (i & 1) == 0;
        for (int half = 0; half < 2; ++half) {
            { pg8::Gemm g{XN, (const bf16*)(ws + W_FFN_IN + (size_t)(half * 4 + i) * SZ_FFN_IN), T, 2 * FF, DM, DM}; pg8::StaticOrder S; S.init(T, 2 * FF, F.G, (int)blockIdx.x);
              pg8::EpiSwiglu E{Gb, FF};
              pg8::gemm_phase<pg8::EpiSwiglu, pg8::StaticOrder, true, true>(F.lds + RING_OFF, g, S, E); }
            GRID_BAR();
            { pg8::Gemm g{Gb, (const bf16*)(ws + W_FFN_OUT + (size_t)(half * 4 + i) * SZ_FFN_OUT), T, DM, FF, FF}; pg8::StaticOrder S; S.init(T, DM, F.G, (int)blockIdx.x);
              pg8::EpiF32 E{Y, DM};
              pg8::gemm_phase<pg8::EpiF32, pg8::StaticOrder, true, true>(F.lds + RING_OFF, g, S, E); }
            GRID_BAR();
            if (half == 1) {
                pg8::Gemm g{PB + (size_t)i * T * PLE, (const bf16*)(ws + W_PROJ + (size_t)i * SZ_PROJ), T, DM, PLE, PLE}; pg8::StaticOrder S; S.init(T, DM, F.G, (int)blockIdx.x);
                pg8::EpiF32 E{PP, DM};
                pg8::gemm_phase<pg8::EpiF32, pg8::StaticOrder, true, true>(F.lds + RING_OFF, g, S, E);
            }
            PHASE();
            norm_pass(F, Y, h, h, args.in[half == 0 ? IN_F1_GPOST : IN_F2_GPOST] + i * DM, 0.5f, args.in[half == 0 ? IN_MIX_GPRE : IN_PLE_GPRE] + i * DM, XN);
            GRID_BAR();
            if (half == 0) {
                if (even) {
                    { pg8::Gemm g{XN, (const bf16*)(ws + W_AB_IN + (size_t)j * SZ_AB_IN), T, AB_INP, DM, DM}; pg8::StaticOrder S; S.init(T, AB_INP, F.G, (int)blockIdx.x);
                      pg8::EpiBf<0> E{U, AB_INP, SSQ, cosB, sinB, NORM_EPS};
                      pg8::gemm_phase<pg8::EpiBf<0>, pg8::StaticOrder, true, true>(F.lds + RING_OFF, g, S, E); }
                    PHASE();
                    if (F.gw == 0) { for (int t = F.lane; t < 8 * 192; t += 64) bias2[t] = args.in[IN_A_BIAS][j * 8 * 192 + t] * LOG2E; }
                    GRID_BAR();
                    { pg8::Gemm g{U + 3072, (const bf16*)(ws + W_QUP + (size_t)j * SZ_QUP), T, QUP_N, 512, AB_INP}; pg8::StaticOrder S; S.init(T, QUP_N, F.G, (int)blockIdx.x);
                      pg8::EpiBf<1> E{QB, QUP_N, SSQ, cosB, sinB, NORM_EPS};
                      pg8::gemm_phase<pg8::EpiBf<1>, pg8::StaticOrder, true, true>(F.lds + RING_OFF, g, S, E); }
                    { pg8::Gemm g{U + 3584, (const bf16*)(ws + W_KVUP + (size_t)j * SZ_KVUP), T, KVUP_N, 256, AB_INP}; pg8::StaticOrder S; S.init(T, KVUP_N, F.G, (int)blockIdx.x);
                      pg8::EpiBf<2> E{KVB, KVUP_N, SSQ, cosB, sinB, NORM_EPS};
                      pg8::gemm_phase<pg8::EpiBf<2>, pg8::StaticOrder, true, true>(F.lds + RING_OFF, g, S, E); }
                    GRID_BAR();
                    PHASE();
                    attn_even_simple(F, U, QB, KVB, OAT, bias2);
                    GRID_BAR();
                } else {
                    { pg8::Gemm g{XN, (const bf16*)(ws + W_C_IN + (size_t)j * SZ_C_IN), T, C_IN, DM, DM}; pg8::StaticOrder S; S.init(T, C_IN, F.G, (int)blockIdx.x);
                      pg8::EpiBf<3> E{U, C_IN, SSQ, cosC, sinC, NORM_EPS};
                      pg8::gemm_phase<pg8::EpiBf<3>, pg8::StaticOrder, true, true>(F.lds + RING_OFF, g, S, E); }
                    GRID_BAR();
                    PHASE();
                    attn_odd_simple(F, U, OS);
                    GRID_BAR();
                    PHASE();
                    csub_pass(F, OS, OAT, args.in[IN_C_LQ1] + j * 128, args.in[IN_C_LK1] + j * 128, args.in[IN_C_LQ2] + j * 128, args.in[IN_C_LK2] + j * 128, args.in[IN_C_GSUB] + j * 256, i);
                    GRID_BAR();
                }
                { pg8::Gemm g{OAT, (const bf16*)(ws + (even ? W_AB_OUT : W_C_OUT) + (size_t)j * SZ_SQ), T, DM, DM, DM}; pg8::StaticOrder S; S.init(T, DM, F.G, (int)blockIdx.x);
                  pg8::EpiF32 E{Y, DM};
                  pg8::gemm_phase<pg8::EpiF32, pg8::StaticOrder, true, true>(F.lds + RING_OFF, g, S, E); }
                GRID_BAR();
                PHASE();
                norm_pass(F, Y, h, h, args.in[IN_MIX_GPOST] + i * DM, 1.0f, args.in[IN_F2_GPRE] + i * DM, XN);
                GRID_BAR();
            } else {
                { pg8::Gemm g{XN, (const bf16*)(ws + W_GATE + (size_t)i * SZ_SQ), T, DM, DM, DM}; pg8::StaticOrder S; S.init(T, DM, F.G, (int)blockIdx.x);
                  pg8::EpiGate E{Y, PP, DM};
                  pg8::gemm_phase<pg8::EpiGate, pg8::StaticOrder, true, true>(F.lds + RING_OFF, g, S, E); }
                GRID_BAR();
                PHASE();
                norm_pass(F, Y, h, h, args.in[IN_PLE_GPOST] + i * DM, 1.0f, i + 1 < NLAYER ? args.in[IN_F1_GPRE] + (i + 1) * DM : nullptr, XN);
                if (i + 1 < NLAYER) GRID_BAR();
            }
        }
    }
}

extern "C" void kernel_launch(void* const* d_in, const int* in_sizes, int n_in, void* d_out, int out_size, void* d_ws, size_t ws_size, hipStream_t stream) {
    static int grid = 0;
    if (grid == 0) {
        if (n_in != 30 || in_sizes[0] != T * DM || out_size != T * DM || ws_size < WS_END) { fprintf(stderr, "kernel_launch: unexpected shapes (n_in %d, in0 %d, out %d, ws %zu); nothing launched\n", n_in, n_in > 0 ? in_sizes[0] : -1, out_size, ws_size); grid = -1; return; }
        int dev = 0, cus = 0, per_cu = 0;
        if (hipGetDevice(&dev) != hipSuccess || hipDeviceGetAttribute(&cus, hipDeviceAttributeMultiprocessorCount, dev) != hipSuccess) { grid = -1; return; }
        if (hipFuncSetAttribute((const void*)fwd_kernel, hipFuncAttributeMaxDynamicSharedMemorySize, LDS_BYTES) != hipSuccess) { fprintf(stderr, "kernel_launch: hipFuncSetAttribute failed\n"); grid = -1; return; }
        if (hipOccupancyMaxActiveBlocksPerMultiprocessor(&per_cu, (const void*)fwd_kernel, NWAVES * 64, LDS_BYTES) != hipSuccess || per_cu < 1) { fprintf(stderr, "kernel_launch: occupancy query says %d\n", per_cu); }
        (void)hipGetLastError();
        grid = cus;
    }
    if (grid < 0) return;
    if (hipMemsetAsync((char*)d_ws + WS_CTL, 0, CTL_ZERO_BYTES, stream) != hipSuccess) return;
    Args a{};
    for (int i = 0; i < 30; ++i) a.in[i] = (const float*)d_in[i];
    a.out = (float*)d_out; a.ws = (unsigned char*)d_ws;
    hipLaunchKernelGGL(fwd_kernel, dim3(grid), dim3(NWAVES * 64), LDS_BYTES, stream, a);
}
```

```cpp
#include <hip/hip_runtime.h>
#include <hip/hip_bf16.h>
#include <cstdio>
#include <cstdint>
#include <cmath>
namespace pg8 {
#define PG8_LAS __attribute__((address_space(3)))
typedef unsigned short bf16_t;
typedef short bf16x8 __attribute__((ext_vector_type(8)));
typedef float f32x4 __attribute__((ext_vector_type(4)));
typedef unsigned u32x4 __attribute__((ext_vector_type(4)));
constexpr int BM = 256, BK = 64, HALF = 128, HTB = HALF * BK * 2  , STAGE_BYTES = 8 * HTB, NXCD = 8, WGM = 8;

__host__ __device__ __forceinline__ int lds_byte(int r, int c) { const int st = (r >> 4) * 2 + (c >> 5), rr = r & 15, cc = c & 31, ob = rr * 64 + cc * 2; return st * 1024 + (ob ^ (((ob >> 9) & 1) << 5)); }
__host__ __device__ __forceinline__ void stage_rc(int b, int& R, int& C) { const int st = b / 1024, sb = b % 1024, swz = sb ^ (((sb >> 9) & 1) << 5); R = (st >> 1) * 16 + swz / 64; C = (st & 1) * 32 + (swz % 64) / 2; }
__host__ __device__ __forceinline__ int perm32(int rho) { const int n = rho >> 4, i = rho & 15; return 8 * (i >> 2) + 4 * n + (i & 3); }

struct Unit { int pm, pn; };
struct Gemm { const bf16_t* A; const bf16_t* Bt; int M, N, K, lda; };

struct StaticOrder {
    int nM, nN, nwg, G, c;
    __host__ __device__ void init(int M, int N, int G_, int c_) { nM = M / BM; nN = N / BM; nwg = nM * nN; G = G_; c = c_; }
    __host__ __device__ bool next(int i, Unit& u) const {
        const long L = (long)i * G + c; if (L >= nwg) return false;
        int wgid = (int)L; { const int q = nwg / NXCD, r = nwg % NXCD, xcd = wgid % NXCD, off = wgid / NXCD; wgid = (xcd < r ? xcd * (q + 1) : r * (q + 1) + (xcd - r) * q) + off; }
        const int nig = WGM * nN, gid = wgid / nig, fm = gid * WGM, gsz = (nM - fm) < WGM ? (nM - fm) : WGM;
        u.pm = fm + ((wgid % nig) % gsz); u.pn = (wgid % nig) / gsz; return true;
    }
    __device__ __forceinline__ void a_ready(const Unit&) const {}
    __device__ __forceinline__ void done(const Unit&) const {}
};

__device__ __forceinline__ unsigned cvt_pk_bf16(float lo, float hi) { unsigned r; asm volatile("v_cvt_pk_bf16_f32 %0, %1, %2" : "=v"(r) : "v"(lo), "v"(hi)); return r; }
typedef float f32x2 __attribute__((ext_vector_type(2)));

constexpr int SEQ_LEN = 2048;
__device__ __forceinline__ float fast_sigmoid(float x) { return __builtin_amdgcn_rcpf(1.0f + __builtin_amdgcn_exp2f(-1.4426950408889634f * x)); }
__device__ __forceinline__ void rope8(f32x4& v0, f32x4& v1, const float* cosT, const float* sinT, int pos, int half, int i0) {
    const f32x4 c = *(const f32x4*)(cosT + (size_t)pos * half + i0), s = *(const f32x4*)(sinT + (size_t)pos * half + i0);
    float a, b;
    a = v0[0]; b = v0[1]; v0[0] = a * c[0] - b * s[0]; v0[1] = b * c[0] + a * s[0];
    a = v0[2]; b = v0[3]; v0[2] = a * c[1] - b * s[1]; v0[3] = b * c[1] + a * s[1];
    a = v1[0]; b = v1[1]; v1[0] = a * c[2] - b * s[2]; v1[1] = b * c[2] + a * s[2];
    a = v1[2]; b = v1[3]; v1[2] = a * c[3] - b * s[3]; v1[3] = b * c[3] + a * s[3];
}
__device__ __forceinline__ void store8_bf16(bf16_t* p, const f32x4& v0, const f32x4& v1) {
    u32x4 w; w.x = cvt_pk_bf16(v0[0], v0[1]); w.y = cvt_pk_bf16(v0[2], v0[3]); w.z = cvt_pk_bf16(v1[0], v1[1]); w.w = cvt_pk_bf16(v1[2], v1[3]); *(u32x4*)p = w;
}
struct EpiF32 {
    static constexpr bool PERM = false, AFTER_DRAIN = false;
    float* C; int ldc;
    __device__ __forceinline__ void operator()(const f32x4 (&acc)[2][2][4][2], const Unit& u, int wr, int wc, int fr, int fq) const {
        const int row0 = u.pm * BM + wr * 64 + fr, col0 = u.pn * BM + wc * 32 + 4 * fq;
#pragma unroll
        for (int ai = 0; ai < 2; ++ai)
#pragma unroll
            for (int m = 0; m < 4; ++m) { float* rowp = C + (size_t)(row0 + ai * HALF + m * 16) * ldc + col0;
#pragma unroll
                for (int bj = 0; bj < 2; ++bj)
#pragma unroll
                    for (int n = 0; n < 2; ++n) *(f32x4*)(rowp + bj * HALF + n * 16) = acc[ai][bj][m][n]; }
    }
};
struct EpiGate {
    static constexpr bool PERM = false, AFTER_DRAIN = false;
    float* C; const float* PP; int ldc;
    __device__ __forceinline__ void operator()(const f32x4 (&acc)[2][2][4][2], const Unit& u, int wr, int wc, int fr, int fq) const {
        const int row0 = u.pm * BM + wr * 64 + fr, col0 = u.pn * BM + wc * 32 + 4 * fq;
#pragma unroll
        for (int ai = 0; ai < 2; ++ai)
#pragma unroll
            for (int m = 0; m < 4; ++m) { const size_t off = (size_t)(row0 + ai * HALF + m * 16) * ldc + col0;
#pragma unroll
                for (int bj = 0; bj < 2; ++bj)
#pragma unroll
                    for (int n = 0; n < 2; ++n) { const f32x4 pp = *(const f32x4*)(PP + off + bj * HALF + n * 16); const f32x4 a = acc[ai][bj][m][n]; f32x4 o;
                        o[0] = fast_sigmoid(a[0]) * pp[0]; o[1] = fast_sigmoid(a[1]) * pp[1]; o[2] = fast_sigmoid(a[2]) * pp[2]; o[3] = fast_sigmoid(a[3]) * pp[3];
                        *(f32x4*)(C + off + bj * HALF + n * 16) = o; } }
    }
};
struct EpiSwiglu {
    static constexpr bool PERM = true, AFTER_DRAIN = false;
    bf16_t* O; int ldc;
    __device__ __forceinline__ void operator()(const f32x4 (&acc)[2][2][4][2], const Unit& u, int wr, int wc, int fr, int fq) const {
        const int row0 = u.pm * BM + wr * 64 + fr, col0 = u.pn * HALF + wc * 32 + 8 * fq;
#pragma unroll
        for (int ai = 0; ai < 2; ++ai)
#pragma unroll
            for (int m = 0; m < 4; ++m) { bf16_t* p = O + (size_t)(row0 + ai * HALF + m * 16) * ldc + col0;
                f32x4 v0, v1; const f32x4 a0 = acc[ai][0][m][0], a1 = acc[ai][0][m][1], b0 = acc[ai][1][m][0], b1 = acc[ai][1][m][1];
#pragma unroll
                for (int e = 0; e < 4; ++e) { v0[e] = a0[e] * fast_sigmoid(a0[e]) * b0[e]; v1[e] = a1[e] * fast_sigmoid(a1[e]) * b1[e]; }
                store8_bf16(p, v0, v1); }
    }
};
template <int KIND> struct EpiBf {
    static constexpr bool PERM = true, AFTER_DRAIN = false;
    bf16_t* O; int ldc; float* ssq; const float* cosT; const float* sinT; float eps;
    __device__ __forceinline__ void operator()(const f32x4 (&acc)[2][2][4][2], const Unit& u, int wr, int wc, int fr, int fq) const {
        const int row0 = u.pm * BM + wr * 64 + fr, col0 = u.pn * BM + wc * 32 + 8 * fq;
#pragma unroll
        for (int ai = 0; ai < 2; ++ai)
#pragma unroll
            for (int m = 0; m < 4; ++m) {
                const int row = row0 + ai * HALF + m * 16, pos = row & (SEQ_LEN - 1);
                bf16_t* p = O + (size_t)row * ldc + col0;
                float rs = 1.f;
                if (KIND == 1) { const f32x4 s0 = *(const f32x4*)(ssq + (size_t)row * 12), s1 = *(const f32x4*)(ssq + (size_t)row * 12 + 4);
                    rs = 1.0f / sqrtf(((s0[0] + s0[1]) + (s0[2] + s0[3]) + (s1[0] + s1[1]) + (s1[2] + s1[3])) * (1.0f / 512.0f) + eps); }
                if (KIND == 2) { const f32x4 s0 = *(const f32x4*)(ssq + (size_t)row * 12 + 8);
                    rs = 1.0f / sqrtf(((s0[0] + s0[1]) + (s0[2] + s0[3])) * (1.0f / 256.0f) + eps); }
                float sq = 0.f;
#pragma unroll
                for (int bj = 0; bj < 2; ++bj) {
                    f32x4 v0 = acc[ai][bj][m][0] * rs, v1 = acc[ai][bj][m][1] * rs;
                    if (KIND == 0) {
                        if (u.pn == 15 && bj == 0 && wc < 2) rope8(v0, v1, cosT, sinT, pos, 32, wc * 16 + 4 * fq);
                        sq += (v0[0] * v0[0] + v0[1] * v0[1]) + (v0[2] * v0[2] + v0[3] * v0[3]) + (v1[0] * v1[0] + v1[1] * v1[1]) + (v1[2] * v1[2] + v1[3] * v1[3]);
                    }
                    if (KIND == 1) { if (u.pn >= 4) rope8(v0, v1, cosT, sinT, pos, 32, (wc & 1) * 16 + 4 * fq); }
                    if (KIND == 3) { if ((u.pn % 3) != 2 && wc == 0) rope8(v0, v1, cosT, sinT, pos, 16, 4 * fq); }
                    store8_bf16(p + bj * HALF, v0, v1);
                }
                if (KIND == 0) {
                    if (u.pn >= 12 && u.pn <= 14) {
                        sq += __shfl_xor(sq, 16); sq += __shfl_xor(sq, 32);
                        if (fq == 0) ssq[(size_t)row * 12 + (u.pn - 12) * 4 + wc] = sq;
                    }
                }
            }
    }
};
template <class Epi, class Sched, bool ALIGN_EPI = false, bool SP2 = false>
__device__ __forceinline__ void gemm_phase(PG8_LAS unsigned char* lds, const Gemm g, const Sched& S, const Epi& E) {
    int tid_ = threadIdx.x; asm volatile("" : "+v"(tid_));
    const int tid = tid_, wid = __builtin_amdgcn_readfirstlane(tid >> 6), lane = tid & 63, wr = wid >> 2, wc = wid & 3, fr = lane & 15, fq = lane >> 4;
    const int K = g.K, nt = K / BK;
    unsigned voffA[2], voffB[2];
#pragma unroll
    for (int i = 0; i < 2; ++i) { int R, C; stage_rc(tid * 16 + i * 8192, R, C); const int Rb = Epi::PERM ? ((R & ~31) + perm32(R & 31)) : R;
        voffA[i] = (unsigned)(R * g.lda + C) * 2u; voffB[i] = (unsigned)(Rb * K + C) * 2u; }
    const size_t kstep = (size_t)(BK * 2);
    const size_t hstep = (size_t)HALF * K * 2;
    const size_t hstepA = (size_t)HALF * g.lda * 2, tstepA = 2 * hstepA;
    const size_t tstep = 2 * hstep;
    const unsigned ldsw = (unsigned)wid * 1024u;
    const int aoff = lds_byte(wr * 64 + fr, fq * 8), boff = lds_byte(wc * 32 + fr, fq * 8);
#define PG8_SA(b, h) (((b) * 2 + (h)) * HTB)
#define PG8_SB(b, h) ((4 + (b) * 2 + (h)) * HTB)
#define PG8_STAGE(bufoff, gbase, voff) do { _Pragma("unroll") for (int _i = 0; _i < 2; ++_i) \
        __builtin_amdgcn_global_load_lds((const unsigned*)((const char*)(gbase) + (voff)[_i]), (PG8_LAS unsigned*)(lds + (bufoff) + ldsw + _i * 8192), 16, 0, 0); } while (0)
#define PG8_LDA(dst, b, h) do { _Pragma("unroll") for (int m = 0; m < 4; ++m) _Pragma("unroll") for (int k = 0; k < 2; ++k) dst[m][k] = *(const PG8_LAS bf16x8*)(lds + PG8_SA(b, h) + aoff + m * 2048 + k * 1024); } while (0)
#define PG8_LDB(dst, b, h) do { _Pragma("unroll") for (int n = 0; n < 2; ++n) _Pragma("unroll") for (int k = 0; k < 2; ++k) dst[n][k] = *(const PG8_LAS bf16x8*)(lds + PG8_SB(b, h) + boff + n * 2048 + k * 1024); } while (0)
#define PG8_MMA(ai, bj, At, Bt) do { __builtin_amdgcn_s_setprio(1); _Pragma("unroll") for (int m = 0; m < 4; ++m) _Pragma("unroll") for (int n = 0; n < 2; ++n) _Pragma("unroll") for (int k = 0; k < 2; ++k) \
        acc[ai][bj][m][n] = __builtin_amdgcn_mfma_f32_16x16x32_bf16(Bt[n][k], At[m][k], acc[ai][bj][m][n], 0, 0, 0); __builtin_amdgcn_s_setprio(0); } while (0)
#define PG8_WAIT_V(n) asm volatile("s_waitcnt vmcnt(" #n ")" ::: "memory")
#define PG8_WAIT_L(n) asm volatile("s_waitcnt lgkmcnt(" #n ")" ::: "memory")
#define PG8_BAR __builtin_amdgcn_s_barrier()
#define PG8_SCHED __builtin_amdgcn_sched_barrier(0)
    Unit cur, nxt; int ui = 0;
    if (!S.next(0, cur)) return;
    f32x4 acc[2][2][4][2];
#pragma unroll
    for (int a = 0; a < 2; ++a)
#pragma unroll
        for (int b = 0; b < 2; ++b)
#pragma unroll
            for (int m = 0; m < 4; ++m)
#pragma unroll
                for (int n = 0; n < 2; ++n) acc[a][b][m][n] = (f32x4){0.f, 0.f, 0.f, 0.f};
    bf16x8 At[4][2], B0[2][2], B1[2][2];
    const char* cA = (const char*)g.A + (size_t)cur.pm * tstepA; const char* cB = (const char*)g.Bt + (size_t)cur.pn * tstep;
    S.a_ready(cur);
    if constexpr (SP2) {
        PG8_STAGE(PG8_SB(0, 0), cB, voffB); PG8_STAGE(PG8_SB(0, 1), cB + hstep, voffB); PG8_STAGE(PG8_SA(0, 0), cA, voffA); PG8_STAGE(PG8_SA(0, 1), cA + hstepA, voffA);
        if (wr == 1) PG8_BAR;
        PG8_WAIT_V(2); PG8_BAR;
        PG8_STAGE(PG8_SB(1, 0), cB + kstep, voffB); PG8_STAGE(PG8_SA(1, 0), cA + kstep, voffA); PG8_STAGE(PG8_SB(1, 1), cB + hstep + kstep, voffB);
        PG8_WAIT_V(6); PG8_BAR;
    } else {
        PG8_STAGE(PG8_SB(0, 0), cB, voffB); PG8_STAGE(PG8_SA(0, 0), cA, voffA); PG8_STAGE(PG8_SB(0, 1), cB + hstep, voffB); PG8_STAGE(PG8_SA(0, 1), cA + hstepA, voffA);
        if (wr == 1) PG8_BAR;
        PG8_WAIT_V(4); PG8_BAR;
        PG8_STAGE(PG8_SB(1, 0), cB + kstep, voffB); PG8_STAGE(PG8_SA(1, 0), cA + kstep, voffA); PG8_STAGE(PG8_SB(1, 1), cB + hstep + kstep, voffB);
        PG8_WAIT_V(6); PG8_BAR;
    }
    for (;;) {
        const bool has_next = S.next(ui + 1, nxt);
        const char* nA = has_next ? (const char*)g.A + (size_t)nxt.pm * tstepA : cA; const char* nB = has_next ? (const char*)g.Bt + (size_t)nxt.pn * tstep : cB;
        for (int t = 0; t < nt; t += 2) {
            const bool last = (t == nt - 2);
            const char* a1 = cA + (size_t)(t + 1) * kstep;
            const char* a2 = last ? nA : cA + (size_t)(t + 2) * kstep; const char* b2 = last ? nB : cB + (size_t)(t + 2) * kstep;
            const char* a3 = a2 + kstep; const char* b3 = b2 + kstep;
            if (last && has_next) S.a_ready(nxt);
            if constexpr (SP2) {
            PG8_LDB(B0, 0, 0); PG8_LDB(B1, 0, 1); PG8_SCHED; PG8_LDA(At, 0, 0); PG8_STAGE(PG8_SA(1, 1), a1 + hstepA, voffA);
            PG8_WAIT_V(8); PG8_WAIT_L(0); PG8_BAR; PG8_MMA(0, 0, At, B0); PG8_MMA(0, 1, At, B1); PG8_BAR; PG8_SCHED;
            PG8_LDA(At, 0, 1); PG8_STAGE(PG8_SB(0, 0), b2, voffB); PG8_STAGE(PG8_SB(0, 1), b2 + hstep, voffB); PG8_STAGE(PG8_SA(0, 0), a2, voffA);
            PG8_WAIT_V(8); PG8_WAIT_L(0); PG8_BAR; PG8_MMA(1, 0, At, B0); PG8_MMA(1, 1, At, B1); PG8_BAR; PG8_SCHED;
            PG8_LDB(B0, 1, 0); PG8_LDB(B1, 1, 1); PG8_SCHED; PG8_LDA(At, 1, 0); PG8_STAGE(PG8_SA(0, 1), a2 + hstepA, voffA);
            PG8_WAIT_V(8); PG8_WAIT_L(0); PG8_BAR; PG8_MMA(0, 0, At, B0); PG8_MMA(0, 1, At, B1); PG8_BAR; PG8_SCHED;
            PG8_LDA(At, 1, 1); PG8_STAGE(PG8_SB(1, 0), b3, voffB); PG8_STAGE(PG8_SB(1, 1), b3 + hstep, voffB); PG8_STAGE(PG8_SA(1, 0), a3, voffA);
            PG8_WAIT_V(8); PG8_WAIT_L(0); PG8_BAR; PG8_MMA(1, 0, At, B0); PG8_MMA(1, 1, At, B1); PG8_BAR; PG8_SCHED;
            } else {
            PG8_LDB(B0, 0, 0); PG8_SCHED; PG8_LDA(At, 0, 0); PG8_STAGE(PG8_SA(1, 1), a1 + hstepA, voffA);
            PG8_WAIT_L(8); PG8_BAR; PG8_WAIT_L(0); PG8_MMA(0, 0, At, B0); PG8_BAR; PG8_SCHED;
            PG8_LDB(B1, 0, 1); PG8_STAGE(PG8_SB(0, 0), b2, voffB);
            PG8_BAR; PG8_WAIT_L(0); PG8_MMA(0, 1, At, B1); PG8_BAR;
            PG8_LDA(At, 0, 1); PG8_STAGE(PG8_SA(0, 0), a2, voffA);
            PG8_BAR; PG8_WAIT_L(0); PG8_MMA(1, 0, At, B0); PG8_BAR; PG8_SCHED;
            PG8_STAGE(PG8_SB(0, 1), b2 + hstep, voffB);
            PG8_WAIT_V(6); PG8_BAR; PG8_MMA(1, 1, At, B1); PG8_BAR;
            PG8_LDB(B0, 1, 0); PG8_SCHED; PG8_LDA(At, 1, 0); PG8_STAGE(PG8_SA(0, 1), a2 + hstepA, voffA);
            PG8_WAIT_L(8); PG8_BAR; PG8_WAIT_L(0); PG8_MMA(0, 0, At, B0); PG8_BAR; PG8_SCHED;
            PG8_LDB(B1, 1, 1); PG8_STAGE(PG8_SB(1, 0), b3, voffB);
            PG8_BAR; PG8_WAIT_L(0); PG8_MMA(0, 1, At, B1); PG8_BAR;
            PG8_LDA(At, 1, 1); PG8_STAGE(PG8_SA(1, 0), a3, voffA);
            PG8_BAR; PG8_WAIT_L(0); PG8_MMA(1, 0, At, B0); PG8_BAR; PG8_SCHED;
            PG8_STAGE(PG8_SB(1, 1), b3 + hstep, voffB);
            PG8_WAIT_V(6); PG8_BAR; PG8_MMA(1, 1, At, B1); PG8_BAR;
            }
        }
        if constexpr (ALIGN_EPI) { if (wr == 0) PG8_BAR; }
        if constexpr (!Epi::AFTER_DRAIN) { E(acc, cur, wr, wc, fr, fq); S.done(cur); }
        if (!has_next) break;
#pragma unroll
        for (int a = 0; a < 2; ++a)
#pragma unroll
            for (int b = 0; b < 2; ++b)
#pragma unroll
                for (int m = 0; m < 4; ++m)
#pragma unroll
                    for (int n = 0; n < 2; ++n) acc[a][b][m][n] = (f32x4){0.f, 0.f, 0.f, 0.f};
        cur = nxt; cA = nA; cB = nB; ++ui;
        if constexpr (ALIGN_EPI) { if (wr == 1) PG8_BAR; }
    }
    PG8_WAIT_V(0);
    if constexpr (!ALIGN_EPI) { if (wr == 0) PG8_BAR; }
    PG8_BAR;
    if constexpr (Epi::AFTER_DRAIN) { E.fused(acc, cur, wr, wc, fr, fq, lds, wid, lane); S.done(cur); }
#undef PG8_SA
#undef PG8_SB
#undef PG8_STAGE
#undef PG8_LDA
#undef PG8_LDB
#undef PG8_MMA
#undef PG8_WAIT_V
#undef PG8_WAIT_L
#undef PG8_BAR
#undef PG8_SCHED
}
}
#define GAS __attribute__((address_space(1)))
#define LAS __attribute__((address_space(3)))
typedef unsigned short bf16;
typedef unsigned v4u __attribute__((ext_vector_type(4)));
typedef float f32x4 __attribute__((ext_vector_type(4)));
typedef short bf16x8 __attribute__((ext_vector_type(8)));
typedef GAS unsigned gu32;
typedef GAS unsigned long long gu64;
#define RLX_AGENT __ATOMIC_RELAXED, __HIP_MEMORY_SCOPE_AGENT
#define LDS_WAIT() asm volatile("s_waitcnt lgkmcnt(0)" ::: "memory")
#define VM_WAIT() asm volatile("s_waitcnt vmcnt(0)" ::: "memory")
__device__ __forceinline__ unsigned long long rt() { return __builtin_amdgcn_s_memrealtime(); }
__device__ __forceinline__ unsigned f2bf(float f) { unsigned u = __builtin_bit_cast(unsigned, f); return (u + 0x7fffu + ((u >> 16) & 1u)) >> 16; }
__device__ __forceinline__ unsigned pk2(float lo, float hi) { return f2bf(lo) | (f2bf(hi) << 16); }

#define XB_TMO      128
#define XB_XCNT(j)  (256  + 64 * (j))
#define XB_XSUB(j)  (1280 + 64 * (j))
#define XB_XGEN(j)  (2304 + 64 * (j))
#define XB_TOP      3328
#define XB_TOPGEN   3392
#define XCD_BAR_WORDS 3456
#define XB_SPIN_CAP (1u << 18)

__device__ __forceinline__ unsigned xb_ld(unsigned* p)              { return __hip_atomic_load(p, __ATOMIC_RELAXED, __HIP_MEMORY_SCOPE_AGENT); }
__device__ __forceinline__ unsigned xb_add(unsigned* p, unsigned v) { return __hip_atomic_fetch_add(p, v, __ATOMIC_RELAXED, __HIP_MEMORY_SCOPE_AGENT); }
__device__ __forceinline__ unsigned xb_xcc_id() { return (unsigned)__builtin_amdgcn_s_getreg((3 << 11) | 20) & 0xFu; }
#define XB_SPIN(cond, bar) do { unsigned _sp = 0; while (cond) { __builtin_amdgcn_s_sleep(1); \
    if ((++_sp & 255u) == 0u) { if (xb_ld(&(bar)[XB_TMO])) break; if (_sp > XB_SPIN_CAP) { atomicAdd(&(bar)[XB_TMO], 1u); break; } } } } while (0)

struct XcdBarrier {
    unsigned* bar; unsigned x;
    volatile LAS unsigned* st;
};

__device__ __forceinline__ XcdBarrier xcd_barrier_post(unsigned* bar, volatile LAS unsigned* st) {
    XcdBarrier b; b.bar = bar; b.x = xb_xcc_id(); b.st = st;
    if (threadIdx.x == 0) (void)xb_add(&bar[XB_XCNT(b.x)], 1u);
    return b;
}
__device__ __forceinline__ void xcd_barrier_complete(unsigned* bar, unsigned x, unsigned& nloc, unsigned& nx) {
    const unsigned G = gridDim.x * gridDim.y * gridDim.z;
    unsigned sum, cnt, mine, sp = 0u;
    for (;;) {
        sum = 0u; cnt = 0u; mine = 0u;
#pragma unroll
        for (unsigned j = 0; j < 16; ++j) { const unsigned c = xb_ld(&bar[XB_XCNT(j)]); sum += c; cnt += (c > 0u) ? 1u : 0u; mine = (j == x) ? c : mine; }
        if (sum == G) break;
        __builtin_amdgcn_s_sleep(1);
        if ((++sp & 255u) == 0u) { if (xb_ld(&bar[XB_TMO])) break; if (sp > XB_SPIN_CAP) { atomicAdd(&bar[XB_TMO], 1u); break; } }
    }
    nloc = mine > 0u ? mine : 1u; nx = cnt > 0u ? cnt : 1u;
}

__device__ __forceinline__ void xcd_barrier(const XcdBarrier& b) {
    asm volatile("s_waitcnt vmcnt(0)" ::: "memory");
    __syncthreads();
    if (threadIdx.x == 0) {
        unsigned* bar = b.bar;
        __builtin_amdgcn_s_waitcnt(0);
        unsigned nloc = b.st[0], nx = b.st[1];
        if (nloc == 0u) { xcd_barrier_complete(bar, b.x, nloc, nx); b.st[0] = nloc; b.st[1] = nx; }
        const unsigned old = xb_add(&bar[XB_XSUB(b.x)], 1u);
        const unsigned gen = old / nloc;
        if (old + 1u == (gen + 1u) * nloc) {
            __builtin_amdgcn_fence(__ATOMIC_RELEASE, "agent");
            asm volatile("s_waitcnt vmcnt(0)" ::: "memory");
            const unsigned og = xb_add(&bar[XB_TOP], 1u);
            const unsigned tg = og / nx;
            if (og + 1u == (tg + 1u) * nx) xb_add(&bar[XB_TOPGEN], 1u);
            else XB_SPIN(xb_ld(&bar[XB_TOPGEN]) == tg, bar);
            __builtin_amdgcn_fence(__ATOMIC_ACQUIRE, "agent");
            xb_add(&bar[XB_XGEN(b.x)], 1u);
            asm volatile("s_waitcnt vmcnt(0)" ::: "memory");
        } else {
            XB_SPIN(xb_ld(&bar[XB_XGEN(b.x)]) == gen, bar);
            __builtin_amdgcn_fence(__ATOMIC_ACQUIRE, "agent");
            asm volatile("s_waitcnt vmcnt(0)" ::: "memory");
        }
    }
    __syncthreads();
}

namespace att {
typedef short bf16x8 __attribute__((ext_vector_type(8)));
typedef short s16x4 __attribute__((ext_vector_type(4)));
typedef float f32x16 __attribute__((ext_vector_type(16)));
typedef unsigned u32x4 __attribute__((ext_vector_type(4)));
typedef LAS char* lptr;
constexpr int NW = 8, QBLK = 32, KVBLK = 64, QB = 256;
constexpr int SHM_V = 16384, SHM_KMAX = 24576;
constexpr int OFF_V = 0, OFF_K = 2 * SHM_V, OFF_WS = OFF_K + 2 * SHM_KMAX, OFF_BIAS = OFF_WS + NW * 64 * 4, ATT_LDS = OFF_BIAS + 1024;
constexpr float THR = 8.f;
#define ATT_SBAR() __builtin_amdgcn_sched_barrier(0)
__device__ __forceinline__ int v_st(int k, int c) { const int kk = (k & ~0xC) | ((k & 4) << 1) | ((k & 8) >> 1); return ((kk >> 3) * 4 + (c >> 5)) * 512 + ((kk & 7) * 32 + (c & 31)) * 2; }
__device__ __forceinline__ int v_rd_base(int lane) { return ((lane & 3) << 3) | (((lane >> 2) & 3) << 6) | (((lane >> 4) & 1) << 5) | (((lane >> 5) & 1) << 8); }
constexpr int v_rd_off(int d0, int ks, int half) { return d0 * 512 + ks * 4096 + half * 2048; }
__device__ __forceinline__ int crow(int r, int hi) { return (r & 3) + 8 * (r >> 2) + 4 * hi; }
__device__ __forceinline__ unsigned cvtpk(float lo, float hi) { unsigned r; asm volatile("v_cvt_pk_bf16_f32 %0, %1, %2" : "=v"(r) : "v"(lo), "v"(hi)); return r; }

__device__ __forceinline__ void partialSM(f32x16& p0, f32x16& p1, float& m_reg, float& mn, float& alpha, float scale, float C2) {
    float pmax = p0[0];
#pragma unroll
    for (int r = 1; r < 16; ++r) pmax = fmaxf(pmax, p0[r]);
#pragma unroll
    for (int r = 0; r < 16; ++r) pmax = fmaxf(pmax, p1[r]);
    { auto rr = __builtin_amdgcn_permlane32_swap(__float_as_uint(pmax), __float_as_uint(pmax), false, false);
      pmax = fmaxf(__uint_as_float(rr[0]), __uint_as_float(rr[1])); }
    if (__builtin_expect(__all((pmax - m_reg) * scale <= THR), 1)) { mn = m_reg; alpha = 1.f; }
    else { mn = fmaxf(m_reg, pmax); alpha = __builtin_amdgcn_exp2f((m_reg - mn) * C2); m_reg = mn; }
    const float mnL = -mn * C2;
#pragma unroll
    for (int r = 0; r < 16; ++r) p0[r] = fmaf(p0[r], C2, mnL);
#pragma unroll
    for (int r = 0; r < 16; ++r) p1[r] = fmaf(p1[r], C2, mnL);
#pragma unroll
    for (int r = 0; r < 16; ++r) p0[r] = __builtin_amdgcn_exp2f(p0[r]);
}
__device__ __forceinline__ void finishSM(f32x16& p0, f32x16& p1, float alpha, float& l_reg, bf16x8& pa0, bf16x8& pa1, bf16x8& pa2, bf16x8& pa3) {
#pragma unroll
    for (int r = 0; r < 16; ++r) p1[r] = __builtin_amdgcn_exp2f(p1[r]);
    float ps = 0;
#pragma unroll
    for (int r = 0; r < 16; ++r) ps += p0[r];
#pragma unroll
    for (int r = 0; r < 16; ++r) ps += p1[r];
    { auto rr = __builtin_amdgcn_permlane32_swap(__float_as_uint(ps), __float_as_uint(ps), false, false);
      ps = __uint_as_float(rr[0]) + __uint_as_float(rr[1]); }
    l_reg = l_reg * alpha + ps;
#define ATT_PK4(P, B_, OUT) do { unsigned a0 = cvtpk(P[B_+0], P[B_+1]), a1 = cvtpk(P[B_+2], P[B_+3]);                          \
        unsigned b0 = cvtpk(P[B_+4], P[B_+5]), b1 = cvtpk(P[B_+6], P[B_+7]);                                             \
        auto r0 = __builtin_amdgcn_permlane32_swap(a0, b0, false, false); auto r1 = __builtin_amdgcn_permlane32_swap(a1, b1, false, false); \
        u32x4 w = {r0[0], r1[0], r0[1], r1[1]}; OUT = __builtin_bit_cast(bf16x8, w); } while (0)
    ATT_PK4(p0, 0, pa0); ATT_PK4(p0, 8, pa1); ATT_PK4(p1, 0, pa2); ATT_PK4(p1, 8, pa3);
#undef ATT_PK4
}
template <int NF, int KP>
__device__ __forceinline__ void qkt(f32x16& p0, f32x16& p1, lptr kbuf, int r32, int hi, const bf16x8* qr) {
    p0 = f32x16{}; p1 = f32x16{};
    lptr kb[4];
#pragma unroll
    for (int dd = 0; dd < 4; ++dd) kb[dd] = kbuf + r32 * KP + (((dd * 16 + hi * 8) * 2) ^ ((r32 & 7) << 4));
#pragma unroll
    for (int d0 = 0; d0 < NF; ++d0) { lptr a = kb[d0 & 3] + (d0 >> 2) * 128;
        const bf16x8 b0 = *(const LAS bf16x8*)a;
        const bf16x8 b1 = *(const LAS bf16x8*)(a + 32 * KP);
        p0 = __builtin_amdgcn_mfma_f32_32x32x16_bf16(b0, qr[d0], p0, 0, 0, 0);
        p1 = __builtin_amdgcn_mfma_f32_32x32x16_bf16(b1, qr[d0], p1, 0, 0, 0); }
}
template <int VB>
__device__ __forceinline__ void pv_tile(f32x16* o, int vb0, bf16x8 pa0, bf16x8 pa1, bf16x8 pa2, bf16x8 pa3) {
#define ATT_TRRD(dst, off) asm volatile("ds_read_b64_tr_b16 %0, %1 offset:%2" : "=&v"(dst) : "v"(vb0), "i"(off) : "memory")
#define ATT_PV_D0(d0) do { s16x4 l0, l1, l2, l3, h0, h1, h2, h3; constexpr int b_ = VB * SHM_V + v_rd_off(d0, 0, 0); \
        ATT_TRRD(l0, b_); ATT_TRRD(h0, b_ + 2048); ATT_TRRD(l1, b_ + 4096); ATT_TRRD(h1, b_ + 6144); ATT_TRRD(l2, b_ + 8192); ATT_TRRD(h2, b_ + 10240); ATT_TRRD(l3, b_ + 12288); ATT_TRRD(h3, b_ + 14336); \
        asm volatile("s_waitcnt lgkmcnt(0)" ::: "memory"); ATT_SBAR();   \
        o[d0] = __builtin_amdgcn_mfma_f32_32x32x16_bf16(pa0, (bf16x8){l0[0], l0[1], l0[2], l0[3], h0[0], h0[1], h0[2], h0[3]}, o[d0], 0, 0, 0);   \
        o[d0] = __builtin_amdgcn_mfma_f32_32x32x16_bf16(pa1, (bf16x8){l1[0], l1[1], l1[2], l1[3], h1[0], h1[1], h1[2], h1[3]}, o[d0], 0, 0, 0);   \
        o[d0] = __builtin_amdgcn_mfma_f32_32x32x16_bf16(pa2, (bf16x8){l2[0], l2[1], l2[2], l2[3], h2[0], h2[1], h2[2], h2[3]}, o[d0], 0, 0, 0);   \
        o[d0] = __builtin_amdgcn_mfma_f32_32x32x16_bf16(pa3, (bf16x8){l3[0], l3[1], l3[2], l3[3], h3[0], h3[1], h3[2], h3[3]}, o[d0], 0, 0, 0); } while (0)
    ATT_PV_D0(0); ATT_PV_D0(1); ATT_PV_D0(2); ATT_PV_D0(3);
#undef ATT_PV_D0
#undef ATT_TRRD
}

struct Blk { const bf16* Q; const bf16* Q2; const bf16* K; const bf16* K2; const bf16* V; void* O; int qp, q2p, kp, k2p, vp, op; int P0, j_lo, j_hi, band; const float* bias; };
template <int DQK, bool BIAS, bool OUTF32>
__device__ __forceinline__ void attn_block(const Blk& B, float scale, lptr lds, int tid) {
    constexpr int NF = DQK / 16, KP = DQK * 2, SHM_K = 64 * KP;
    const int wid = __builtin_amdgcn_readfirstlane(tid >> 6), lane = tid & 63, r32 = lane & 31, hi = lane >> 5;
    lptr V_lds = lds + OFF_V; lptr K_lds = lds + OFF_K;
    LAS float* wsf = (LAS float*)(lds + OFF_WS) + wid * 64; LAS float* li_l = wsf; LAS float* al_l = wsf + 32;
    LAS float* bias_l = (LAS float*)(lds + OFF_BIAS);
    const float C2 = scale * 1.4426950408889634f;
    bf16x8 qr[NF];
    { const bf16* qrow = B.Q + (size_t)(wid * QBLK + r32) * B.qp + hi * 8;
#pragma unroll
      for (int d0 = 0; d0 < 8; ++d0) qr[d0] = *(const GAS bf16x8*)(qrow + d0 * 16);
      if constexpr (DQK == 192) { const bf16* q2row = B.Q2 + (size_t)(wid * QBLK + r32) * B.q2p + hi * 8;
#pragma unroll
          for (int d0 = 0; d0 < 4; ++d0) qr[8 + d0] = *(const GAS bf16x8*)(q2row + d0 * 16); } }
    if constexpr (BIAS) { if (tid < 192) bias_l[tid] = B.bias[tid] / scale; }
    const int sr = tid >> 4, sc = (tid & 15) * 8;
    const int vst0 = v_st(sr, sc), vst1 = v_st(32 + sr, sc);
    const int kws = sr * KP + ((sc * 2) ^ ((sr & 7) << 4));
    const int sr2 = tid >> 3, sc2 = (tid & 7) * 8;
    const int kws2 = sr2 * KP + ((256 + sc2 * 2) ^ ((sr2 & 7) << 4));
    const int vb0 = (int)(unsigned)(uintptr_t)V_lds + v_rd_base(lane);
    const bf16* kg = B.K + (size_t)sr * B.kp + sc; const bf16* vg = B.V + (size_t)sr * B.vp + sc; const bf16* k2g = (DQK == 192) ? B.K2 + (size_t)sr2 * B.k2p + sc2 : nullptr;
    bf16x8 st_k0, st_k1, st_k2, st_v0, st_v1;
#define ATT_SLOAD(k0) do { st_k0 = *(const GAS bf16x8*)(kg + (size_t)(k0) * B.kp); st_k1 = *(const GAS bf16x8*)(kg + (size_t)((k0) + 32) * B.kp); \
                           st_v0 = *(const GAS bf16x8*)(vg + (size_t)(k0) * B.vp); st_v1 = *(const GAS bf16x8*)(vg + (size_t)((k0) + 32) * B.vp); \
                           if constexpr (DQK == 192) st_k2 = *(const GAS bf16x8*)(k2g + (size_t)(k0) * B.k2p); } while (0)
#define ATT_SWRITE(bf) do { *(LAS bf16x8*)(K_lds + (bf) * SHM_K + kws) = st_k0; *(LAS bf16x8*)(K_lds + (bf) * SHM_K + kws + 32 * KP) = st_k1; \
                            *(LAS bf16x8*)(V_lds + (bf) * SHM_V + vst0) = st_v0; *(LAS bf16x8*)(V_lds + (bf) * SHM_V + vst1) = st_v1; \
                            if constexpr (DQK == 192) *(LAS bf16x8*)(K_lds + (bf) * SHM_K + kws2) = st_k2; } while (0)
    const int NT = B.j_hi - B.j_lo;
    const int qlo = B.P0 + wid * QBLK, qc = qlo >> 6;
    float m_reg = -1e30f, l_reg = 0.f; f32x16 o[4] = {};
    f32x16 pA0, pA1; float mnA, alA; bf16x8 pa0, pa1, pa2, pa3;
    ATT_SLOAD(B.j_lo * KVBLK);
    asm volatile("s_waitcnt vmcnt(0)" ::: "memory");
    ATT_SWRITE(0);
    __syncthreads();
#define ATT_STEP(t, BUF) do {                                                                                           \
        if ((t) + 1 < NT) ATT_SLOAD((B.j_lo + (t) + 1) * KVBLK);                                                            \
        ATT_SBAR();                                                                                                         \
        { const int kc = B.j_lo + (t);                                                                                      \
          if (kc <= qc && kc >= qc - B.band) {                                                                              \
            qkt<NF, KP>(pA0, pA1, K_lds + (BUF) * SHM_K, r32, hi, qr);                                                      \
            if constexpr (BIAS) {                                                                                           \
                const int jd = qc - kc;                                                                                     \
                if (jd >= 3) { const float cb = bias_l[191];                                                               \
                    _Pragma("unroll") for (int r = 0; r < 16; ++r) { pA0[r] += cb; pA1[r] += cb; } }                        \
                else { const int base = (qlo + r32) - (kc * KVBLK + 4 * hi) + 63;                                           \
                    _Pragma("unroll") for (int r = 0; r < 16; ++r) { const int i0 = base - ((r & 3) + 8 * (r >> 2)), i1 = i0 - 32; \
                        pA0[r] += bias_l[i0 > 191 ? 191 : i0]; pA1[r] += bias_l[i1 > 191 ? 191 : i1]; } }                   \
            }                                                                                                               \
            partialSM(pA0, pA1, m_reg, mnA, alA, scale, C2);                                                                \
            if (__any(alA < 1.f)) { if (hi == 0) al_l[r32] = alA; asm volatile("s_waitcnt lgkmcnt(0)" ::: "memory");        \
                _Pragma("unroll") for (int d_ = 0; d_ < 4; ++d_) _Pragma("unroll") for (int r = 0; r < 16; ++r) o[d_][r] *= al_l[crow(r, hi)]; } \
            finishSM(pA0, pA1, alA, l_reg, pa0, pa1, pa2, pa3); ATT_SBAR();                                                 \
            pv_tile<BUF>(o, vb0, pa0, pa1, pa2, pa3);                                                                       \
          } }                                                                                                               \
        ATT_SBAR();                                                                                                         \
        if ((t) + 1 < NT) { asm volatile("s_waitcnt vmcnt(0)" ::: "memory"); ATT_SWRITE((BUF) ^ 1); }                       \
        __syncthreads(); } while (0)
    for (int t = 0; t < NT; t += 2) { ATT_STEP(t, 0); ATT_STEP(t + 1, 1); }
    if (hi == 0) li_l[r32] = l_reg;
    asm volatile("s_waitcnt lgkmcnt(0)" ::: "memory");
    float rli[16];
#pragma unroll
    for (int r = 0; r < 16; ++r) rli[r] = __builtin_amdgcn_rcpf(li_l[crow(r, hi)]);
#pragma unroll
    for (int r = 0; r < 16; ++r) { const int orow = wid * QBLK + crow(r, hi);
#pragma unroll
        for (int d0 = 0; d0 < 4; ++d0) { const float v = o[d0][r] * rli[r];
            if constexpr (OUTF32) { ((GAS float*)B.O)[(size_t)orow * B.op + d0 * 32 + r32] = v; }
            else { const float vn = __shfl_xor(v, 1);
                   if ((r32 & 1) == 0) *(GAS unsigned*)((bf16*)B.O + (size_t)orow * B.op + d0 * 32 + r32) = cvtpk(v, vn); } } }
    __syncthreads();
#undef ATT_STEP
#undef ATT_SLOAD
#undef ATT_SWRITE
}
#undef ATT_SBAR
}
#ifndef ATT_A_MFMA
#define ATT_A_MFMA 1
#endif
#ifndef ATT_B_MFMA
#define ATT_B_MFMA 1
#endif
#ifndef ATT_C_MFMA
#define ATT_C_MFMA 1
#endif

constexpr int NWAVES = 8;
constexpr int T = 8192, SEQ = 2048, DM = 2048, FF = 5632, NLAYER = 4, PLE = 256;
constexpr int AB_IN = 3904, AB_INP = 4096, C_IN = 6144, QUP_N = 1536, KVUP_N = 2048;
constexpr float NORM_EPS = 1e-6f;
constexpr size_t MiB = 1u << 20;
constexpr size_t WS_CTL = 0, CTL_ZERO_BYTES = 1 * MiB;
constexpr size_t WS_ROPE = 1 * MiB;
constexpr size_t WS_SSQ = 2 * MiB;
constexpr size_t WS_PB = 4 * MiB;
constexpr size_t WS_W = 20 * MiB;
constexpr size_t W_FFN_IN = WS_W, SZ_FFN_IN = 44 * MiB;
constexpr size_t W_FFN_OUT = W_FFN_IN + 8 * SZ_FFN_IN, SZ_FFN_OUT = 22 * MiB;
constexpr size_t W_AB_IN = W_FFN_OUT + 8 * SZ_FFN_OUT, SZ_AB_IN = 16 * MiB;
constexpr size_t W_QUP = W_AB_IN + 2 * SZ_AB_IN, SZ_QUP = 3 * MiB / 2;
constexpr size_t W_KVUP = W_QUP + 2 * SZ_QUP, SZ_KVUP = 1 * MiB;
constexpr size_t W_AB_OUT = W_KVUP + 2 * SZ_KVUP, SZ_SQ = 8 * MiB;
constexpr size_t W_C_IN = W_AB_OUT + 2 * SZ_SQ, SZ_C_IN = 24 * MiB;
constexpr size_t W_C_OUT = W_C_IN + 2 * SZ_C_IN;
constexpr size_t W_GATE = W_C_OUT + 2 * SZ_SQ;
constexpr size_t W_PROJ = W_GATE + 4 * SZ_SQ, SZ_PROJ = 1 * MiB;
constexpr size_t W_END = W_PROJ + 4 * SZ_PROJ;
constexpr size_t WS_XN = 704 * MiB;
constexpr size_t WS_G = 736 * MiB;
constexpr size_t WS_Y = 824 * MiB;
constexpr size_t WS_U = 888 * MiB;
constexpr size_t WS_QB = 984 * MiB;
constexpr size_t WS_KVB = 1008 * MiB;
constexpr size_t WS_OAT = 1040 * MiB;
constexpr size_t WS_OS = 1072 * MiB;
constexpr size_t WS_PP = 1200 * MiB;
constexpr size_t WS_END = 1264 * MiB;
static_assert(W_END <= WS_XN, "weights overflow");
constexpr int CW_BAR = 4096;

constexpr int RING_OFF = 0, RING_BYTES = 131072;
constexpr int LDSCTL_OFF = RING_BYTES, MISC_OFF = LDSCTL_OFF + 320;
constexpr int LDS_BYTES = 147456;
static_assert(MISC_OFF + 128 <= LDS_BYTES, "LDS map");

struct Frame {
    LAS unsigned char* lds;
    int tid, lane, wave, gw, NGW, G;
};
__device__ __forceinline__ float wave_sum(float v) {
#pragma unroll
    for (int o = 1; o < 64; o <<= 1) v += __shfl_xor(v, o);
    return v;
}
__device__ __forceinline__ int il_pair(int r, int half) { return r < half ? 2 * r : 2 * (r - half) + 1; }
__device__ __forceinline__ int wmap(int kind, int n) {
    switch (kind) {
        case 1: { const int r = n >= FF ? 1 : 0, j = n - r * FF; return (j >> 7) * 256 + r * 128 + (j & 127); }
        case 2: return n < 3840 ? n : 3840 + il_pair(n - 3840, 32);
        case 3: { const int h = n / 192, d = n % 192; return d < 128 ? h * 128 + d : 1024 + h * 64 + il_pair(d - 128, 32); }
        case 4: { const int h = n >> 8, d = n & 255; return d < 128 ? h * 128 + d : 1024 + h * 128 + (d - 128); }
        case 5: { const int h = n / 768, r = n % 768; if (r >= 512) return n; const int part = r >> 7, d = r & 127; return h * 768 + part * 128 + (d < 32 ? il_pair(d, 16) : d); }
        default: return n;
    }
}
__device__ __forceinline__ void transpose_item(const float* W, int K, int N, bf16* WT, int kind, const float* gain, LAS float* scr, int item, int lane) {
    const int nblk = N / 32, kb = item / nblk, nb = item % nblk, k0 = 64 * kb, n0 = 32 * nb;
#pragma unroll 8
    for (int i = 0; i < 32; ++i) { const int kk = 2 * i + (lane >> 5); float w = W[(size_t)(k0 + kk) * N + n0 + (lane & 31)]; if (gain) w *= gain[k0 + kk]; scr[kk * 33 + (lane & 31)] = w; }
    LDS_WAIT(); asm volatile("" ::: "memory");
    const int c = lane & 7;
#pragma unroll
    for (int j = 0; j < 4; ++j) { const int n = (lane >> 3) + 8 * j; const LAS float* s = scr + (8 * c) * 33 + n;
        v4u o; o.x = pk2(s[0 * 33], s[1 * 33]); o.y = pk2(s[2 * 33], s[3 * 33]); o.z = pk2(s[4 * 33], s[5 * 33]); o.w = pk2(s[6 * 33], s[7 * 33]);
        *(GAS v4u*)(WT + (size_t)wmap(kind, n0 + n) * K + k0 + 8 * c) = o; }
    LDS_WAIT(); asm volatile("" ::: "memory");
}
__device__ __forceinline__ void transpose_all(const Frame& F, const float* W, int K, int N, bf16* WT, int kind, const float* gain) {
    LAS float* scr = (LAS float*)(F.lds + RING_OFF + F.wave * 16384);
    const int nitems = (K / 64) * (N / 32);
    for (int it = F.gw; it < nitems; it += F.NGW) transpose_item(W, K, N, WT, kind, gain, scr, it, F.lane);
}
__device__ __forceinline__ void norm_pass(const Frame& F, const float* y, const float* hin, float* hout, const float* g_post, float coef, const float* g_pre, bf16* xn) {
    for (int row = F.gw; row < T; row += F.NGW) {
        const GAS f32x4* hr = (const GAS f32x4*)(hin + (size_t)row * DM) + F.lane;
        f32x4 hv[8];
#pragma unroll
        for (int j = 0; j < 8; ++j) hv[j] = hr[64 * j];
        if (y) {
            const GAS f32x4* yr = (const GAS f32x4*)(y + (size_t)row * DM) + F.lane;
            f32x4 yv[8]; float s = 0.f;
#pragma unroll
            for (int j = 0; j < 8; ++j) { yv[j] = yr[64 * j]; s += (yv[j].x * yv[j].x + yv[j].y * yv[j].y) + (yv[j].z * yv[j].z + yv[j].w * yv[j].w); }
            const float rstd = coef / sqrtf(wave_sum(s) * (1.f / DM) + NORM_EPS);
#pragma unroll
            for (int j = 0; j < 8; ++j) { const f32x4 g = *((const GAS f32x4*)g_post + F.lane + 64 * j); hv[j] = hv[j] + yv[j] * rstd * g; }
        }
        GAS f32x4* ho = (GAS f32x4*)(hout + (size_t)row * DM) + F.lane;
#pragma unroll
        for (int j = 0; j < 8; ++j) ho[64 * j] = hv[j];
        if (g_pre) {
            float s2 = 0.f;
#pragma unroll
            for (int j = 0; j < 8; ++j) s2 += (hv[j].x * hv[j].x + hv[j].y * hv[j].y) + (hv[j].z * hv[j].z + hv[j].w * hv[j].w);
            const float rstd2 = 1.f / sqrtf(wave_sum(s2) * (1.f / DM) + NORM_EPS);
            GAS unsigned long long* o8 = (GAS unsigned long long*)(xn + (size_t)row * DM) + F.lane;
#pragma unroll
            for (int j = 0; j < 8; ++j) { const f32x4 g = *((const GAS f32x4*)g_pre + F.lane + 64 * j); const f32x4 v = hv[j] * rstd2 * g;
                o8[64 * j] = (unsigned long long)pg8::cvt_pk_bf16(v.x, v.y) | ((unsigned long long)pg8::cvt_pk_bf16(v.z, v.w) << 32); }
        }
    }
}

typedef __bf16 bf16x2_t __attribute__((ext_vector_type(2)));
__device__ __forceinline__ float dot2bf(unsigned a, unsigned b, float c) { return __builtin_amdgcn_fdot2_f32_bf16(__builtin_bit_cast(bf16x2_t, a), __builtin_bit_cast(bf16x2_t, b), c, false); }
template <int DQK, bool BIAS, int VC>
__device__ __forceinline__ void sattn_wave(const bf16* qa, const bf16* qb, const bf16* ka, size_t pka, const bf16* kb, size_t pkb, const bf16* v, size_t pv,
                                           int j0, int j1, float sc2, const float* bias2  , int qpos, int kpos0, float (&acc)[VC]) {
    constexpr int NQ = DQK / 2;
    unsigned qp[NQ];
#pragma unroll
    for (int c = 0; c < 16; ++c) { const v4u w = *(const GAS v4u*)(qa + 8 * c); qp[4 * c] = w.x; qp[4 * c + 1] = w.y; qp[4 * c + 2] = w.z; qp[4 * c + 3] = w.w; }
    if constexpr (DQK == 192) {
#pragma unroll
        for (int c = 0; c < 8; ++c) { const v4u w = *(const GAS v4u*)(qb + 8 * c); qp[64 + 4 * c] = w.x; qp[64 + 4 * c + 1] = w.y; qp[64 + 4 * c + 2] = w.z; qp[64 + 4 * c + 3] = w.w; }
    }
#pragma unroll
    for (int c = 0; c < VC; ++c) acc[c] = 0.f;
    float m = -1e30f, l = 0.f;
#pragma unroll 1
    for (int j = j0; j < j1; ++j) {
        const GAS v4u* kr = (const GAS v4u*)(ka + (size_t)j * pka);
        float d0 = 0.f, d1 = 0.f;
#pragma unroll
        for (int c = 0; c < 16; ++c) { const v4u w = kr[c]; d0 = dot2bf(w.x, qp[4 * c], d0); d1 = dot2bf(w.y, qp[4 * c + 1], d1); d0 = dot2bf(w.z, qp[4 * c + 2], d0); d1 = dot2bf(w.w, qp[4 * c + 3], d1); }
        if constexpr (DQK == 192) {
            const GAS v4u* kr2 = (const GAS v4u*)(kb + (size_t)j * pkb);
#pragma unroll
            for (int c = 0; c < 8; ++c) { const v4u w = kr2[c]; d0 = dot2bf(w.x, qp[64 + 4 * c], d0); d1 = dot2bf(w.y, qp[64 + 4 * c + 1], d1); d0 = dot2bf(w.z, qp[64 + 4 * c + 2], d0); d1 = dot2bf(w.w, qp[64 + 4 * c + 3], d1); }
        }
        float sv = (d0 + d1) * sc2;
        if constexpr (BIAS) { int dist = qpos - (kpos0 + (j - j0)); dist = dist < -63 ? -63 : (dist > 128 ? 128 : dist); sv += bias2[dist + 63]; }
        const float mn = fmaxf(m, sv), alpha = __builtin_amdgcn_exp2f(m - mn), pw = __builtin_amdgcn_exp2f(sv - mn);
        m = mn; l = l * alpha + pw;
        const GAS v4u* vr = (const GAS v4u*)(v + (size_t)j * pv);
#pragma unroll
        for (int c = 0; c < VC / 8; ++c) { const v4u w = vr[c];
            acc[8 * c + 0] = acc[8 * c + 0] * alpha + pw * __uint_as_float(w.x << 16); acc[8 * c + 1] = acc[8 * c + 1] * alpha + pw * __uint_as_float(w.x & 0xffff0000u);
            acc[8 * c + 2] = acc[8 * c + 2] * alpha + pw * __uint_as_float(w.y << 16); acc[8 * c + 3] = acc[8 * c + 3] * alpha + pw * __uint_as_float(w.y & 0xffff0000u);
            acc[8 * c + 4] = acc[8 * c + 4] * alpha + pw * __uint_as_float(w.z << 16); acc[8 * c + 5] = acc[8 * c + 5] * alpha + pw * __uint_as_float(w.z & 0xffff0000u);
            acc[8 * c + 6] = acc[8 * c + 6] * alpha + pw * __uint_as_float(w.w << 16); acc[8 * c + 7] = acc[8 * c + 7] * alpha + pw * __uint_as_float(w.w & 0xffff0000u); }
    }
    const float rl = 1.0f / l;
#pragma unroll
    for (int c = 0; c < VC; ++c) acc[c] *= rl;
}
template <int VC> __device__ __forceinline__ void storeN_bf16(bf16* o, const float (&acc)[VC]) {
#pragma unroll
    for (int c = 0; c < VC / 8; ++c) { v4u w; w.x = pg8::cvt_pk_bf16(acc[8 * c], acc[8 * c + 1]); w.y = pg8::cvt_pk_bf16(acc[8 * c + 2], acc[8 * c + 3]); w.z = pg8::cvt_pk_bf16(acc[8 * c + 4], acc[8 * c + 5]); w.w = pg8::cvt_pk_bf16(acc[8 * c + 6], acc[8 * c + 7]);
        *(GAS v4u*)(o + 8 * c) = w; }
}
__device__ __forceinline__ void store64_f32(float* o, const float (&acc)[64]) {
#pragma unroll
    for (int c = 0; c < 16; ++c) *(GAS f32x4*)(o + 4 * c) = (f32x4){acc[4 * c], acc[4 * c + 1], acc[4 * c + 2], acc[4 * c + 3]};
}
constexpr float LOG2E = 1.4426950408889634f;
__device__ __forceinline__ void attn_even_simple(const Frame& F, const bf16* U, const bf16* QB, const bf16* KVB, bf16* OAT, const float* bias2  ) {
#if !ATT_A_MFMA
    for (int u = F.gw; u < 2048; u += F.NGW) {
        float acc[64];
        const int n = u & 31, r = u >> 5, slice = r & 1, h = (r >> 1) & 7, b = r >> 4;
        const int row = b * SEQ + n * 64 + F.lane, nlo = n >= 8 ? n - 8 : 0;
        sattn_wave<128, true, 64>(U + (size_t)row * AB_INP + h * 128, nullptr, U + 1024 + h * 128, AB_INP, nullptr, 0, U + 2048 + h * 128 + slice * 64, AB_INP,
                                  b * SEQ + nlo * 64, b * SEQ + (n + 1) * 64, 0.08838834764831845f * LOG2E, bias2 + h * 192, n * 64 + F.lane, nlo * 64, acc);
        storeN_bf16<64>(OAT + (size_t)row * DM + h * 128 + slice * 64, acc);
    }
#endif
#if !ATT_B_MFMA
    for (int u = F.gw; u < 4096; u += F.NGW) {
        float acc[32];
        const int k = u >> 11, w = u & 2047, nb = w & 31, n = k ? 31 - nb : nb, r = (w >> 5) + 64 * k, slice = r & 3, h = (r >> 2) & 7, b = r >> 5;
        const int row = b * SEQ + n * 64 + F.lane;
        sattn_wave<192, false, 32>(QB + (size_t)row * QUP_N + h * 128, QB + (size_t)row * QUP_N + 1024 + h * 64, KVB + h * 128, KVUP_N, U + 3840, AB_INP, KVB + 1024 + h * 128 + slice * 32, KVUP_N,
                                   b * SEQ, b * SEQ + (n + 1) * 64, 0.07216878364870322f * LOG2E, nullptr, 0, 0, acc);
        storeN_bf16<32>(OAT + (size_t)row * DM + 1024 + h * 128 + slice * 32, acc);
    }
#endif
}
__device__ __forceinline__ void attn_odd_simple(const Frame& F, const bf16* U, float* OS) {
    float acc[64];
    for (int u = F.gw; u < 8192; u += F.NGW) {
        const int k = u >> 11, w = u & 2047, nb = w & 31, n = (k & 1) ? 31 - nb : nb, r = (w >> 5) + 64 * k, slice = r & 3, s = (r >> 2) & 1, h = (r >> 3) & 7, b = r >> 6;
        const int row = b * SEQ + n * 64 + F.lane;
        sattn_wave<128, false, 64>(U + (size_t)row * C_IN + h * 768 + s * 128, nullptr, U + h * 768 + 256 + s * 128, C_IN, nullptr, 0, U + h * 768 + 512 + slice * 64, C_IN,
                               b * SEQ, b * SEQ + (n + 1) * 64, 0.08838834764831845f * LOG2E, nullptr, 0, 0, acc);
        store64_f32(OS + (size_t)s * T * DM + (size_t)row * DM + h * 256 + slice * 64, acc);
    }
}
__device__ __forceinline__ void attn_even_mfma(const Frame& F, const bf16* U, const bf16* QB, const bf16* KVB, bf16* OAT, const float* relbias  ) {
    att::lptr lds = (att::lptr)(F.lds + RING_OFF);
    for (int it = blockIdx.x; it < 256; it += F.G) {
        const int qbB = it & 7, h = (it >> 3) & 7, b = it >> 6, qbA = 7 - qbB;
#if ATT_B_MFMA
        { att::Blk B; const size_t r0 = (size_t)b * SEQ + qbB * 256, k0 = (size_t)b * SEQ;
          B.Q = QB + r0 * QUP_N + h * 128; B.Q2 = QB + r0 * QUP_N + 1024 + h * 64; B.K = KVB + k0 * KVUP_N + h * 128; B.K2 = U + k0 * AB_INP + 3840; B.V = KVB + k0 * KVUP_N + 1024 + h * 128;
          B.O = OAT + r0 * DM + 1024 + h * 128; B.qp = QUP_N; B.q2p = QUP_N; B.kp = KVUP_N; B.k2p = AB_INP; B.vp = KVUP_N; B.op = DM; B.P0 = qbB * 256; B.j_lo = 0; B.j_hi = 4 * qbB + 4; B.band = 1 << 20; B.bias = nullptr;
          att::attn_block<192, false, false>(B, 0.07216878364870322f, lds, F.tid); }
#endif
#if ATT_A_MFMA
        { att::Blk B; const size_t r0 = (size_t)b * SEQ + qbA * 256, k0 = (size_t)b * SEQ;
          B.Q = U + r0 * AB_INP + h * 128; B.Q2 = nullptr; B.K = U + k0 * AB_INP + 1024 + h * 128; B.K2 = nullptr; B.V = U + k0 * AB_INP + 2048 + h * 128;
          B.O = OAT + r0 * DM + h * 128; B.qp = AB_INP; B.q2p = 0; B.kp = AB_INP; B.k2p = 0; B.vp = AB_INP; B.op = DM; B.P0 = qbA * 256; B.j_lo = qbA >= 2 ? 4 * qbA - 8 : 0; B.j_hi = 4 * qbA + 4; B.band = 8; B.bias = relbias + h * 192;
          att::attn_block<128, true, false>(B, 0.08838834764831845f, lds, F.tid); }
#endif
    }
}
__device__ __forceinline__ void attn_odd_mfma(const Frame& F, const bf16* U, float* OS) {
    att::lptr lds = (att::lptr)(F.lds + RING_OFF);
    for (int it = blockIdx.x; it < 512; it += F.G) {
        const int x = it & 3, r = it >> 2, vh = r & 1, s = (r >> 1) & 1, h = (r >> 2) & 7, b = r >> 5;
        for (int pass = 0; pass < 2; ++pass) {
            const int qb = pass ? x : 7 - x;
            att::Blk B; const size_t r0 = (size_t)b * SEQ + qb * 256, k0 = (size_t)b * SEQ;
            B.Q = U + r0 * C_IN + h * 768 + s * 128; B.Q2 = nullptr; B.K = U + k0 * C_IN + h * 768 + 256 + s * 128; B.K2 = nullptr; B.V = U + k0 * C_IN + h * 768 + 512 + vh * 128;
            B.O = OS + (size_t)s * T * DM + r0 * DM + h * 256 + vh * 128; B.qp = C_IN; B.q2p = 0; B.kp = C_IN; B.k2p = 0; B.vp = C_IN; B.op = DM; B.P0 = qb * 256; B.j_lo = 0; B.j_hi = 4 * qb + 4; B.band = 1 << 20; B.bias = nullptr;
            att::attn_block<128, false, true>(B, 0.08838834764831845f, lds, F.tid);
        }
    }
}
__device__ __forceinline__ void csub_pass(const Frame& F, const float* OS, bf16* OAT, const float* lq1, const float* lk1, const float* lq2, const float* lk2, const float* g_sub, int layer) {
    asm volatile("" : "+s"(layer));
    const float lambda_init = 0.8f - 0.6f * expf(-0.3f * (float)layer);
    const float d1 = wave_sum(lq1[F.lane] * lk1[F.lane] + lq1[F.lane + 64] * lk1[F.lane + 64]);
    const float d2 = wave_sum(lq2[F.lane] * lk2[F.lane] + lq2[F.lane + 64] * lk2[F.lane + 64]);
    const float lam = expf(d1) - expf(d2) + lambda_init, post = 1.0f - lambda_init;
    const f32x4 g = *((const GAS f32x4*)g_sub + F.lane);
    for (int row = F.gw; row < T; row += F.NGW) {
#pragma unroll
        for (int h = 0; h < 8; ++h) {
            const f32x4 o1 = *((const GAS f32x4*)(OS + (size_t)row * DM + h * 256) + F.lane), o2 = *((const GAS f32x4*)(OS + (size_t)T * DM + (size_t)row * DM + h * 256) + F.lane);
            const f32x4 d = o1 - o2 * lam;
            const float ss = wave_sum((d.x * d.x + d.y * d.y) + (d.z * d.z + d.w * d.w));
            const float rstd = post / sqrtf(ss * (1.f / 256.f) + NORM_EPS);
            const f32x4 o = d * rstd * g;
            *((GAS unsigned long long*)(OAT + (size_t)row * DM + h * 256) + F.lane) = (unsigned long long)pg8::cvt_pk_bf16(o.x, o.y) | ((unsigned long long)pg8::cvt_pk_bf16(o.z, o.w) << 32);
        }
    }
}

struct Args { const float* in[30]; float* out; unsigned char* ws; };
enum { IN_X = 0, IN_P, IN_F1_GPRE, IN_F1_WIN, IN_F1_WOUT, IN_F1_GPOST, IN_MIX_GPRE, IN_MIX_GPOST, IN_AB_WIN, IN_A_BIAS, IN_B_GQ, IN_B_WQUP, IN_B_GKV, IN_B_WKVUP, IN_AB_WOUT,
       IN_C_WIN, IN_C_LQ1, IN_C_LK1, IN_C_LQ2, IN_C_LK2, IN_C_GSUB, IN_C_WOUT, IN_F2_GPRE, IN_F2_WIN, IN_F2_WOUT, IN_F2_GPOST, IN_PLE_GPRE, IN_PLE_WGATE, IN_PLE_WPROJ, IN_PLE_GPOST };

__global__ void __launch_bounds__(NWAVES * 64, 2) fwd_kernel(Args args) {
    extern __shared__ __attribute__((aligned(16))) unsigned char lds[];
    Frame F;
    F.lds = (LAS unsigned char*)lds;
    volatile LAS unsigned* MISC = (volatile LAS unsigned*)(F.lds + MISC_OFF);
    F.tid = threadIdx.x; F.lane = F.tid & 63; F.wave = __builtin_amdgcn_readfirstlane(F.tid >> 6);
    F.G = gridDim.x; F.gw = blockIdx.x * NWAVES + F.wave; F.NGW = F.G * NWAVES;
    unsigned char* ws = args.ws;
    gu32* ctl = (gu32*)(ws + WS_CTL);
    for (int u = F.tid; u < (LDS_BYTES - LDSCTL_OFF) / 4; u += NWAVES * 64) ((LAS unsigned*)(F.lds + LDSCTL_OFF))[u] = 0u;
    __syncthreads();
    XcdBarrier bar = xcd_barrier_post((unsigned*)(ctl + CW_BAR), MISC + 8);
#define GRID_BAR() do { XcdBarrier b_ = bar; asm volatile("" : "+s"(b_.bar), "+s"(b_.x)); xcd_barrier(b_); } while (0)
#define PHASE() do { int t_ = threadIdx.x; asm volatile("" : "+v"(t_)); F.tid = t_; F.lane = t_ & 63; } while (0)

    float* const h = args.out;
    float* cosB = (float*)(ws + WS_ROPE); float* sinB = cosB + 2048 * 32; float* cosC = sinB + 2048 * 32; float* sinC = cosC + 2048 * 16;
    float* bias2 = sinC + 2048 * 16;
    float* SSQ = (float*)(ws + WS_SSQ);
    bf16* PB = (bf16*)(ws + WS_PB);
    bf16* XN = (bf16*)(ws + WS_XN); bf16* Gb = (bf16*)(ws + WS_G); float* Y = (float*)(ws + WS_Y); bf16* U = (bf16*)(ws + WS_U);
    bf16* QB = (bf16*)(ws + WS_QB); bf16* KVB = (bf16*)(ws + WS_KVB); bf16* OAT = (bf16*)(ws + WS_OAT); float* OS = (float*)(ws + WS_OS); float* PP = (float*)(ws + WS_PP);

    {
        PHASE();
        for (int l = 0; l < NLAYER; ++l) {
            transpose_all(F, args.in[IN_F1_WIN] + (size_t)l * DM * 2 * FF, DM, 2 * FF, (bf16*)(ws + W_FFN_IN + (size_t)(0 * 4 + l) * SZ_FFN_IN), 1, nullptr);
            transpose_all(F, args.in[IN_F2_WIN] + (size_t)l * DM * 2 * FF, DM, 2 * FF, (bf16*)(ws + W_FFN_IN + (size_t)(1 * 4 + l) * SZ_FFN_IN), 1, nullptr);
            transpose_all(F, args.in[IN_F1_WOUT] + (size_t)l * FF * DM, FF, DM, (bf16*)(ws + W_FFN_OUT + (size_t)(0 * 4 + l) * SZ_FFN_OUT), 0, nullptr);
            transpose_all(F, args.in[IN_F2_WOUT] + (size_t)l * FF * DM, FF, DM, (bf16*)(ws + W_FFN_OUT + (size_t)(1 * 4 + l) * SZ_FFN_OUT), 0, nullptr);
            transpose_all(F, args.in[IN_PLE_WGATE] + (size_t)l * DM * DM, DM, DM, (bf16*)(ws + W_GATE + (size_t)l * SZ_SQ), 0, nullptr);
            transpose_all(F, args.in[IN_PLE_WPROJ] + (size_t)l * PLE * DM, PLE, DM, (bf16*)(ws + W_PROJ + (size_t)l * SZ_PROJ), 0, nullptr);
        }
        for (int j = 0; j < 2; ++j) {
            transpose_all(F, args.in[IN_AB_WIN] + (size_t)j * DM * AB_IN, DM, AB_IN, (bf16*)(ws + W_AB_IN + (size_t)j * SZ_AB_IN), 2, nullptr);
            transpose_all(F, args.in[IN_B_WQUP] + (size_t)j * 512 * QUP_N, 512, QUP_N, (bf16*)(ws + W_QUP + (size_t)j * SZ_QUP), 3, args.in[IN_B_GQ] + j * 512);
            transpose_all(F, args.in[IN_B_WKVUP] + (size_t)j * 256 * KVUP_N, 256, KVUP_N, (bf16*)(ws + W_KVUP + (size_t)j * SZ_KVUP), 4, args.in[IN_B_GKV] + j * 256);
            transpose_all(F, args.in[IN_AB_WOUT] + (size_t)j * DM * DM, DM, DM, (bf16*)(ws + W_AB_OUT + (size_t)j * SZ_SQ), 0, nullptr);
            transpose_all(F, args.in[IN_C_WIN] + (size_t)j * DM * C_IN, DM, C_IN, (bf16*)(ws + W_C_IN + (size_t)j * SZ_C_IN), 5, nullptr);
            transpose_all(F, args.in[IN_C_WOUT] + (size_t)j * DM * DM, DM, DM, (bf16*)(ws + W_C_OUT + (size_t)j * SZ_SQ), 0, nullptr);
            { GAS v4u* z = (GAS v4u*)(ws + W_AB_IN + (size_t)j * SZ_AB_IN + (size_t)AB_IN * DM * 2); const int nz = (AB_INP - AB_IN) * DM * 2 / 16;
              for (int i = blockIdx.x * (NWAVES * 64) + F.tid; i < nz; i += F.G * NWAVES * 64) z[i] = (v4u){0u, 0u, 0u, 0u}; }
        }
        for (int i = blockIdx.x * (NWAVES * 64) + F.tid; i < 2048 * 32; i += F.G * NWAVES * 64) { const int pos = i >> 5, f = i & 31; const float inv = powf(500000.0f, -(float)(2 * f) / 64.0f), ang = (float)pos * inv; cosB[i] = cosf(ang); sinB[i] = sinf(ang); }
        for (int i = blockIdx.x * (NWAVES * 64) + F.tid; i < 2048 * 16; i += F.G * NWAVES * 64) { const int pos = i >> 4, f = i & 15; const float inv = powf(500000.0f, -(float)(2 * f) / 32.0f), ang = (float)pos * inv; cosC[i] = cosf(ang); sinC[i] = sinf(ang); }
        { const GAS f32x4* src = (const GAS f32x4*)args.in[IN_P]; GAS unsigned long long* dst = (GAS unsigned long long*)PB; const int n4 = NLAYER * T * PLE / 4;
          for (int i = blockIdx.x * (NWAVES * 64) + F.tid; i < n4; i += F.G * NWAVES * 64) { const f32x4 v = src[i]; dst[i] = (unsigned long long)pg8::cvt_pk_bf16(v.x, v.y) | ((unsigned long long)pg8::cvt_pk_bf16(v.z, v.w) << 32); } }
        norm_pass(F, nullptr, args.in[IN_X], h, nullptr, 0.f, args.in[IN_F1_GPRE], XN);
    }
    GRID_BAR();

    for (int i = 0; i < NLAYER; ++i) {
        const int j = i >> 1; const bool even = (i & 1) == 0;
        for (int half = 0; half < 2; ++half) {
            { pg8::Gemm g{XN, (const bf16*)(ws + W_FFN_IN + (size_t)(half * 4 + i) * SZ_FFN_IN), T, 2 * FF, DM, DM}; pg8::StaticOrder S; S.init(T, 2 * FF, F.G, (int)blockIdx.x);
              pg8::EpiSwiglu E{Gb, FF};
              pg8::gemm_phase<pg8::EpiSwiglu, pg8::StaticOrder, true, true>(F.lds + RING_OFF, g, S, E); }
            GRID_BAR();
            { pg8::Gemm g{Gb, (const bf16*)(ws + W_FFN_OUT + (size_t)(half * 4 + i) * SZ_FFN_OUT), T, DM, FF, FF}; pg8::StaticOrder S; S.init(T, DM, F.G, (int)blockIdx.x);
              pg8::EpiF32 E{Y, DM};
              pg8::gemm_phase<pg8::EpiF32, pg8::StaticOrder, true, true>(F.lds + RING_OFF, g, S, E); }
            GRID_BAR();
            if (half == 1) {
                pg8::Gemm g{PB + (size_t)i * T * PLE, (const bf16*)(ws + W_PROJ + (size_t)i * SZ_PROJ), T, DM, PLE, PLE}; pg8::StaticOrder S; S.init(T, DM, F.G, (int)blockIdx.x);
                pg8::EpiF32 E{PP, DM};
                pg8::gemm_phase<pg8::EpiF32, pg8::StaticOrder, true, true>(F.lds + RING_OFF, g, S, E);
            }
            PHASE();
            norm_pass(F, Y, h, h, args.in[half == 0 ? IN_F1_GPOST : IN_F2_GPOST] + i * DM, 0.5f, args.in[half == 0 ? IN_MIX_GPRE : IN_PLE_GPRE] + i * DM, XN);
            GRID_BAR();
            if (half == 0) {
                if (even) {
                    { pg8::Gemm g{XN, (const bf16*)(ws + W_AB_IN + (size_t)j * SZ_AB_IN), T, AB_INP, DM, DM}; pg8::StaticOrder S; S.init(T, AB_INP, F.G, (int)blockIdx.x);
                      pg8::EpiBf<0> E{U, AB_INP, SSQ, cosB, sinB, NORM_EPS};
                      pg8::gemm_phase<pg8::EpiBf<0>, pg8::StaticOrder, true, true>(F.lds + RING_OFF, g, S, E); }
                    PHASE();
                    if (F.gw == 0) { for (int t = F.lane; t < 8 * 192; t += 64) bias2[t] = args.in[IN_A_BIAS][j * 8 * 192 + t] * LOG2E; }
                    GRID_BAR();
                    { pg8::Gemm g{U + 3072, (const bf16*)(ws + W_QUP + (size_t)j * SZ_QUP), T, QUP_N, 512, AB_INP}; pg8::StaticOrder S; S.init(T, QUP_N, F.G, (int)blockIdx.x);
                      pg8::EpiBf<1> E{QB, QUP_N, SSQ, cosB, sinB, NORM_EPS};
                      pg8::gemm_phase<pg8::EpiBf<1>, pg8::StaticOrder, true, true>(F.lds + RING_OFF, g, S, E); }
                    { pg8::Gemm g{U + 3584, (const bf16*)(ws + W_KVUP + (size_t)j * SZ_KVUP), T, KVUP_N, 256, AB_INP}; pg8::StaticOrder S; S.init(T, KVUP_N, F.G, (int)blockIdx.x);
                      pg8::EpiBf<2> E{KVB, KVUP_N, SSQ, cosB, sinB, NORM_EPS};
                      pg8::gemm_phase<pg8::EpiBf<2>, pg8::StaticOrder, true, true>(F.lds + RING_OFF, g, S, E); }
                    GRID_BAR();
                    PHASE();
#if ATT_A_MFMA || ATT_B_MFMA
                    attn_even_mfma(F, U, QB, KVB, OAT, args.in[IN_A_BIAS] + j * 8 * 192);
#endif
#if !(ATT_A_MFMA && ATT_B_MFMA)
                    attn_even_simple(F, U, QB, KVB, OAT, bias2);
#endif
                    GRID_BAR();
                } else {
                    { pg8::Gemm g{XN, (const bf16*)(ws + W_C_IN + (size_t)j * SZ_C_IN), T, C_IN, DM, DM}; pg8::StaticOrder S; S.init(T, C_IN, F.G, (int)blockIdx.x);
                      pg8::EpiBf<3> E{U, C_IN, SSQ, cosC, sinC, NORM_EPS};
                      pg8::gemm_phase<pg8::EpiBf<3>, pg8::StaticOrder, true, true>(F.lds + RING_OFF, g, S, E); }
                    GRID_BAR();
                    PHASE();
#if ATT_C_MFMA
                    attn_odd_mfma(F, U, OS);
#else
                    attn_odd_simple(F, U, OS);
#endif
                    GRID_BAR();
                    PHASE();
                    csub_pass(F, OS, OAT, args.in[IN_C_LQ1] + j * 128, args.in[IN_C_LK1] + j * 128, args.in[IN_C_LQ2] + j * 128, args.in[IN_C_LK2] + j * 128, args.in[IN_C_GSUB] + j * 256, i);
                    GRID_BAR();
                }
                { pg8::Gemm g{OAT, (const bf16*)(ws + (even ? W_AB_OUT : W_C_OUT) + (size_t)j * SZ_SQ), T, DM, DM, DM}; pg8::StaticOrder S; S.init(T, DM, F.G, (int)blockIdx.x);
                  pg8::EpiF32 E{Y, DM};
                  pg8::gemm_phase<pg8::EpiF32, pg8::StaticOrder, true, true>(F.lds + RING_OFF, g, S, E); }
                GRID_BAR();
                PHASE();
                norm_pass(F, Y, h, h, args.in[IN_MIX_GPOST] + i * DM, 1.0f, args.in[IN_F2_GPRE] + i * DM, XN);
                GRID_BAR();
            } else {
                { pg8::Gemm g{XN, (const bf16*)(ws + W_GATE + (size_t)i * SZ_SQ), T, DM, DM, DM}; pg8::StaticOrder S; S.init(T, DM, F.G, (int)blockIdx.x);
                  pg8::EpiGate E{Y, PP, DM};
                  pg8::gemm_phase<pg8::EpiGate, pg8::StaticOrder, true, true>(F.lds + RING_OFF, g, S, E); }
                GRID_BAR();
                PHASE();
                norm_pass(F, Y, h, h, args.in[IN_PLE_GPOST] + i * DM, 1.0f, i + 1 < NLAYER ? args.in[IN_F1_GPRE] + (i + 1) * DM : nullptr, XN);
                if (i + 1 < NLAYER) GRID_BAR();
            }
        }
    }
}

extern "C" void kernel_launch(void* const* d_in, const int* in_sizes, int n_in, void* d_out, int out_size, void* d_ws, size_t ws_size, hipStream_t stream) {
    static int grid = 0;
    if (grid == 0) {
        if (n_in != 30 || in_sizes[0] != T * DM || out_size != T * DM || ws_size < WS_END) { fprintf(stderr, "kernel_launch: unexpected shapes (n_in %d, in0 %d, out %d, ws %zu); nothing launched\n", n_in, n_in > 0 ? in_sizes[0] : -1, out_size, ws_size); grid = -1; return; }
        int dev = 0, cus = 0, per_cu = 0;
        if (hipGetDevice(&dev) != hipSuccess || hipDeviceGetAttribute(&cus, hipDeviceAttributeMultiprocessorCount, dev) != hipSuccess) { grid = -1; return; }
        if (hipFuncSetAttribute((const void*)fwd_kernel, hipFuncAttributeMaxDynamicSharedMemorySize, LDS_BYTES) != hipSuccess) { fprintf(stderr, "kernel_launch: hipFuncSetAttribute failed\n"); grid = -1; return; }
        if (hipOccupancyMaxActiveBlocksPerMultiprocessor(&per_cu, (const void*)fwd_kernel, NWAVES * 64, LDS_BYTES) != hipSuccess || per_cu < 1) { fprintf(stderr, "kernel_launch: occupancy query says %d\n", per_cu); }
        (void)hipGetLastError();
        grid = cus;
    }
    if (grid < 0) return;
    if (hipMemsetAsync((char*)d_ws + WS_CTL, 0, CTL_ZERO_BYTES, stream) != hipSuccess) return;
    Args a{};
    for (int i = 0; i < 30; ++i) a.in[i] = (const float*)d_in[i];
    a.out = (float*)d_out; a.ws = (unsigned char*)d_ws;
    hipLaunchKernelGGL(fwd_kernel, dim3(grid), dim3(NWAVES * 64), LDS_BYTES, stream, a);
}
```

```cpp
#include <hip/hip_runtime.h>
#include <hip/hip_bf16.h>
#include <cstdio>
#include <cstdint>
#include <cmath>
namespace pg8 {
#define PG8_LAS __attribute__((address_space(3)))
typedef unsigned short bf16_t;
typedef short bf16x8 __attribute__((ext_vector_type(8)));
typedef float f32x4 __attribute__((ext_vector_type(4)));
typedef unsigned u32x4 __attribute__((ext_vector_type(4)));
constexpr int BM = 256, BK = 64, HALF = 128, HTB = HALF * BK * 2  , STAGE_BYTES = 8 * HTB, NXCD = 8, WGM = 8;

__host__ __device__ __forceinline__ int lds_byte(int r, int c) { const int st = (r >> 4) * 2 + (c >> 5), rr = r & 15, cc = c & 31, ob = rr * 64 + cc * 2; return st * 1024 + (ob ^ (((ob >> 9) & 1) << 5)); }
__host__ __device__ __forceinline__ void stage_rc(int b, int& R, int& C) { const int st = b / 1024, sb = b % 1024, swz = sb ^ (((sb >> 9) & 1) << 5); R = (st >> 1) * 16 + swz / 64; C = (st & 1) * 32 + (swz % 64) / 2; }
__host__ __device__ __forceinline__ int perm32(int rho) { const int n = rho >> 4, i = rho & 15; return 8 * (i >> 2) + 4 * n + (i & 3); }

struct Unit { int pm, pn; };
struct Gemm { const bf16_t* A; const bf16_t* Bt; int M, N, K, lda; };

struct StaticOrder {
    int nM, nN, nwg, G, c;
    __host__ __device__ void init(int M, int N, int G_, int c_) { nM = M / BM; nN = N / BM; nwg = nM * nN; G = G_; c = c_; }
    __host__ __device__ bool next(int i, Unit& u) const {
        const long L = (long)i * G + c; if (L >= nwg) return false;
        int wgid = (int)L; { const int q = nwg / NXCD, r = nwg % NXCD, xcd = wgid % NXCD, off = wgid / NXCD; wgid = (xcd < r ? xcd * (q + 1) : r * (q + 1) + (xcd - r) * q) + off; }
        const int nig = WGM * nN, gid = wgid / nig, fm = gid * WGM, gsz = (nM - fm) < WGM ? (nM - fm) : WGM;
        u.pm = fm + ((wgid % nig) % gsz); u.pn = (wgid % nig) / gsz; return true;
    }
    __device__ __forceinline__ void a_ready(const Unit&) const {}
    __device__ __forceinline__ void done(const Unit&) const {}
};

__device__ __forceinline__ unsigned cvt_pk_bf16(float lo, float hi) { unsigned r; asm volatile("v_cvt_pk_bf16_f32 %0, %1, %2" : "=v"(r) : "v"(lo), "v"(hi)); return r; }
typedef float f32x2 __attribute__((ext_vector_type(2)));

constexpr int SEQ_LEN = 2048;
__device__ __forceinline__ float fast_sigmoid(float x) { return __builtin_amdgcn_rcpf(1.0f + __builtin_amdgcn_exp2f(-1.4426950408889634f * x)); }
__device__ __forceinline__ void rope8(f32x4& v0, f32x4& v1, const float* cosT, const float* sinT, int pos, int half, int i0) {
    const f32x4 c = *(const f32x4*)(cosT + (size_t)pos * half + i0), s = *(const f32x4*)(sinT + (size_t)pos * half + i0);
    float a, b;
    a = v0[0]; b = v0[1]; v0[0] = a * c[0] - b * s[0]; v0[1] = b * c[0] + a * s[0];
    a = v0[2]; b = v0[3]; v0[2] = a * c[1] - b * s[1]; v0[3] = b * c[1] + a * s[1];
    a = v1[0]; b = v1[1]; v1[0] = a * c[2] - b * s[2]; v1[1] = b * c[2] + a * s[2];
    a = v1[2]; b = v1[3]; v1[2] = a * c[3] - b * s[3]; v1[3] = b * c[3] + a * s[3];
}
__device__ __forceinline__ void store8_bf16(bf16_t* p, const f32x4& v0, const f32x4& v1) {
    u32x4 w; w.x = cvt_pk_bf16(v0[0], v0[1]); w.y = cvt_pk_bf16(v0[2], v0[3]); w.z = cvt_pk_bf16(v1[0], v1[1]); w.w = cvt_pk_bf16(v1[2], v1[3]); *(u32x4*)p = w;
}
struct EpiF32 {
    static constexpr bool PERM = false, AFTER_DRAIN = false;
    float* C; int ldc;
    __device__ __forceinline__ void operator()(const f32x4 (&acc)[2][2][4][2], const Unit& u, int wr, int wc, int fr, int fq) const {
        const int row0 = u.pm * BM + wr * 64 + fr, col0 = u.pn * BM + wc * 32 + 4 * fq;
#pragma unroll
        for (int ai = 0; ai < 2; ++ai)
#pragma unroll
            for (int m = 0; m < 4; ++m) { float* rowp = C + (size_t)(row0 + ai * HALF + m * 16) * ldc + col0;
#pragma unroll
                for (int bj = 0; bj < 2; ++bj)
#pragma unroll
                    for (int n = 0; n < 2; ++n) *(f32x4*)(rowp + bj * HALF + n * 16) = acc[ai][bj][m][n]; }
    }
};
struct EpiGate {
    static constexpr bool PERM = false, AFTER_DRAIN = false;
    float* C; const float* PP; int ldc;
    __device__ __forceinline__ void operator()(const f32x4 (&acc)[2][2][4][2], const Unit& u, int wr, int wc, int fr, int fq) const {
        const int row0 = u.pm * BM + wr * 64 + fr, col0 = u.pn * BM + wc * 32 + 4 * fq;
#pragma unroll
        for (int ai = 0; ai < 2; ++ai)
#pragma unroll
            for (int m = 0; m < 4; ++m) { const size_t off = (size_t)(row0 + ai * HALF + m * 16) * ldc + col0;
#pragma unroll
                for (int bj = 0; bj < 2; ++bj)
#pragma unroll
                    for (int n = 0; n < 2; ++n) { const f32x4 pp = *(const f32x4*)(PP + off + bj * HALF + n * 16); const f32x4 a = acc[ai][bj][m][n]; f32x4 o;
                        o[0] = fast_sigmoid(a[0]) * pp[0]; o[1] = fast_sigmoid(a[1]) * pp[1]; o[2] = fast_sigmoid(a[2]) * pp[2]; o[3] = fast_sigmoid(a[3]) * pp[3];
                        *(f32x4*)(C + off + bj * HALF + n * 16) = o; } }
    }
};
struct EpiSwiglu {
    static constexpr bool PERM = true, AFTER_DRAIN = false;
    bf16_t* O; int ldc;
    __device__ __forceinline__ void operator()(const f32x4 (&acc)[2][2][4][2], const Unit& u, int wr, int wc, int fr, int fq) const {
        const int row0 = u.pm * BM + wr * 64 + fr, col0 = u.pn * HALF + wc * 32 + 8 * fq;
#pragma unroll
        for (int ai = 0; ai < 2; ++ai)
#pragma unroll
            for (int m = 0; m < 4; ++m) { bf16_t* p = O + (size_t)(row0 + ai * HALF + m * 16) * ldc + col0;
                f32x4 v0, v1; const f32x4 a0 = acc[ai][0][m][0], a1 = acc[ai][0][m][1], b0 = acc[ai][1][m][0], b1 = acc[ai][1][m][1];
#pragma unroll
                for (int e = 0; e < 4; ++e) { v0[e] = a0[e] * fast_sigmoid(a0[e]) * b0[e]; v1[e] = a1[e] * fast_sigmoid(a1[e]) * b1[e]; }
                store8_bf16(p, v0, v1); }
    }
};
template <int KIND> struct EpiBf {
    static constexpr bool PERM = true, AFTER_DRAIN = false;
    bf16_t* O; int ldc; float* ssq; const float* cosT; const float* sinT; float eps;
    __device__ __forceinline__ void operator()(const f32x4 (&acc)[2][2][4][2], const Unit& u, int wr, int wc, int fr, int fq) const {
        const int row0 = u.pm * BM + wr * 64 + fr, col0 = u.pn * BM + wc * 32 + 8 * fq;
#pragma unroll
        for (int ai = 0; ai < 2; ++ai)
#pragma unroll
            for (int m = 0; m < 4; ++m) {
                const int row = row0 + ai * HALF + m * 16, pos = row & (SEQ_LEN - 1);
                bf16_t* p = O + (size_t)row * ldc + col0;
                float rs = 1.f;
                if (KIND == 1) { const f32x4 s0 = *(const f32x4*)(ssq + (size_t)row * 12), s1 = *(const f32x4*)(ssq + (size_t)row * 12 + 4);
                    rs = 1.0f / sqrtf(((s0[0] + s0[1]) + (s0[2] + s0[3]) + (s1[0] + s1[1]) + (s1[2] + s1[3])) * (1.0f / 512.0f) + eps); }
                if (KIND == 2) { const f32x4 s0 = *(const f32x4*)(ssq + (size_t)row * 12 + 8);
                    rs = 1.0f / sqrtf(((s0[0] + s0[1]) + (s0[2] + s0[3])) * (1.0f / 256.0f) + eps); }
                float sq = 0.f;
#pragma unroll
                for (int bj = 0; bj < 2; ++bj) {
                    f32x4 v0 = acc[ai][bj][m][0] * rs, v1 = acc[ai][bj][m][1] * rs;
                    if (KIND == 0) {
                        if (u.pn == 15 && bj == 0 && wc < 2) rope8(v0, v1, cosT, sinT, pos, 32, wc * 16 + 4 * fq);
                        sq += (v0[0] * v0[0] + v0[1] * v0[1]) + (v0[2] * v0[2] + v0[3] * v0[3]) + (v1[0] * v1[0] + v1[1] * v1[1]) + (v1[2] * v1[2] + v1[3] * v1[3]);
                    }
                    if (KIND == 1) { if (u.pn >= 4) rope8(v0, v1, cosT, sinT, pos, 32, (wc & 1) * 16 + 4 * fq); }
                    if (KIND == 3) { if ((u.pn % 3) != 2 && wc == 0) rope8(v0, v1, cosT, sinT, pos, 16, 4 * fq); }
                    store8_bf16(p + bj * HALF, v0, v1);
                }
                if (KIND == 0) {
                    if (u.pn >= 12 && u.pn <= 14) {
                        sq += __shfl_xor(sq, 16); sq += __shfl_xor(sq, 32);
                        if (fq == 0) ssq[(size_t)row * 12 + (u.pn - 12) * 4 + wc] = sq;
                    }
                }
            }
    }
};
template <class Epi, class Sched, bool ALIGN_EPI = false, bool SP2 = false>
__device__ __forceinline__ void gemm_phase(PG8_LAS unsigned char* lds, const Gemm g, const Sched& S, const Epi& E, const int tid_in  ) {
    const int tid = tid_in, wid = __builtin_amdgcn_readfirstlane(tid >> 6), lane = tid & 63, wr = wid >> 2, wc = wid & 3, fr = lane & 15, fq = lane >> 4;
    const int K = g.K, nt = K / BK;
    unsigned voffA[2], voffB[2];
#pragma unroll
    for (int i = 0; i < 2; ++i) { int R, C; stage_rc(tid * 16 + i * 8192, R, C); const int Rb = Epi::PERM ? ((R & ~31) + perm32(R & 31)) : R;
        voffA[i] = (unsigned)(R * g.lda + C) * 2u; voffB[i] = (unsigned)(Rb * K + C) * 2u; }
    const size_t kstep = (size_t)(BK * 2);
    const size_t hstep = (size_t)HALF * K * 2;
    const size_t hstepA = (size_t)HALF * g.lda * 2, tstepA = 2 * hstepA;
    const size_t tstep = 2 * hstep;
    const unsigned ldsw = (unsigned)wid * 1024u;
    const int aoff = lds_byte(wr * 64 + fr, fq * 8), boff = lds_byte(wc * 32 + fr, fq * 8);
#define PG8_SA(b, h) (((b) * 2 + (h)) * HTB)
#define PG8_SB(b, h) ((4 + (b) * 2 + (h)) * HTB)
#define PG8_STAGE(bufoff, gbase, voff) do { _Pragma("unroll") for (int _i = 0; _i < 2; ++_i) \
        __builtin_amdgcn_global_load_lds((const unsigned*)((const char*)(gbase) + (voff)[_i]), (PG8_LAS unsigned*)(lds + (bufoff) + ldsw + _i * 8192), 16, 0, 0); } while (0)
#define PG8_LDA(dst, b, h) do { _Pragma("unroll") for (int m = 0; m < 4; ++m) _Pragma("unroll") for (int k = 0; k < 2; ++k) dst[m][k] = *(const PG8_LAS bf16x8*)(lds + PG8_SA(b, h) + aoff + m * 2048 + k * 1024); } while (0)
#define PG8_LDB(dst, b, h) do { _Pragma("unroll") for (int n = 0; n < 2; ++n) _Pragma("unroll") for (int k = 0; k < 2; ++k) dst[n][k] = *(const PG8_LAS bf16x8*)(lds + PG8_SB(b, h) + boff + n * 2048 + k * 1024); } while (0)
#define PG8_MMA(ai, bj, At, Bt) do { __builtin_amdgcn_s_setprio(1); _Pragma("unroll") for (int m = 0; m < 4; ++m) _Pragma("unroll") for (int n = 0; n < 2; ++n) _Pragma("unroll") for (int k = 0; k < 2; ++k) \
        acc[ai][bj][m][n] = __builtin_amdgcn_mfma_f32_16x16x32_bf16(Bt[n][k], At[m][k], acc[ai][bj][m][n], 0, 0, 0); __builtin_amdgcn_s_setprio(0); } while (0)
#define PG8_WAIT_V(n) asm volatile("s_waitcnt vmcnt(" #n ")" ::: "memory")
#define PG8_WAIT_L(n) asm volatile("s_waitcnt lgkmcnt(" #n ")" ::: "memory")
#define PG8_BAR __builtin_amdgcn_s_barrier()
#define PG8_SCHED __builtin_amdgcn_sched_barrier(0)
    Unit cur, nxt; int ui = 0;
    if (!S.next(0, cur)) return;
    f32x4 acc[2][2][4][2];
#pragma unroll
    for (int a = 0; a < 2; ++a)
#pragma unroll
        for (int b = 0; b < 2; ++b)
#pragma unroll
            for (int m = 0; m < 4; ++m)
#pragma unroll
                for (int n = 0; n < 2; ++n) acc[a][b][m][n] = (f32x4){0.f, 0.f, 0.f, 0.f};
    bf16x8 At[4][2], B0[2][2], B1[2][2];
    const char* cA = (const char*)g.A + (size_t)cur.pm * tstepA; const char* cB = (const char*)g.Bt + (size_t)cur.pn * tstep;
    S.a_ready(cur);
    if constexpr (SP2) {
        PG8_STAGE(PG8_SB(0, 0), cB, voffB); PG8_STAGE(PG8_SB(0, 1), cB + hstep, voffB); PG8_STAGE(PG8_SA(0, 0), cA, voffA); PG8_STAGE(PG8_SA(0, 1), cA + hstepA, voffA);
        if (wr == 1) PG8_BAR;
        PG8_WAIT_V(2); PG8_BAR;
        PG8_STAGE(PG8_SB(1, 0), cB + kstep, voffB); PG8_STAGE(PG8_SA(1, 0), cA + kstep, voffA); PG8_STAGE(PG8_SB(1, 1), cB + hstep + kstep, voffB);
        PG8_WAIT_V(6); PG8_BAR;
    } else {
        PG8_STAGE(PG8_SB(0, 0), cB, voffB); PG8_STAGE(PG8_SA(0, 0), cA, voffA); PG8_STAGE(PG8_SB(0, 1), cB + hstep, voffB); PG8_STAGE(PG8_SA(0, 1), cA + hstepA, voffA);
        if (wr == 1) PG8_BAR;
        PG8_WAIT_V(4); PG8_BAR;
        PG8_STAGE(PG8_SB(1, 0), cB + kstep, voffB); PG8_STAGE(PG8_SA(1, 0), cA + kstep, voffA); PG8_STAGE(PG8_SB(1, 1), cB + hstep + kstep, voffB);
        PG8_WAIT_V(6); PG8_BAR;
    }
    for (;;) {
        const bool has_next = S.next(ui + 1, nxt);
        const char* nA = has_next ? (const char*)g.A + (size_t)nxt.pm * tstepA : cA; const char* nB = has_next ? (const char*)g.Bt + (size_t)nxt.pn * tstep : cB;
        for (int t = 0; t < nt; t += 2) {
            const bool last = (t == nt - 2);
            const char* a1 = cA + (size_t)(t + 1) * kstep;
            const char* a2 = last ? nA : cA + (size_t)(t + 2) * kstep; const char* b2 = last ? nB : cB + (size_t)(t + 2) * kstep;
            const char* a3 = a2 + kstep; const char* b3 = b2 + kstep;
            if (last && has_next) S.a_ready(nxt);
            if constexpr (SP2) {
            PG8_LDB(B0, 0, 0); PG8_LDB(B1, 0, 1); PG8_SCHED; PG8_LDA(At, 0, 0); PG8_STAGE(PG8_SA(1, 1), a1 + hstepA, voffA);
            PG8_WAIT_V(8); PG8_WAIT_L(0); PG8_BAR; PG8_MMA(0, 0, At, B0); PG8_MMA(0, 1, At, B1); PG8_BAR; PG8_SCHED;
            PG8_LDA(At, 0, 1); PG8_STAGE(PG8_SB(0, 0), b2, voffB); PG8_STAGE(PG8_SB(0, 1), b2 + hstep, voffB); PG8_STAGE(PG8_SA(0, 0), a2, voffA);
            PG8_WAIT_V(8); PG8_WAIT_L(0); PG8_BAR; PG8_MMA(1, 0, At, B0); PG8_MMA(1, 1, At, B1); PG8_BAR; PG8_SCHED;
            PG8_LDB(B0, 1, 0); PG8_LDB(B1, 1, 1); PG8_SCHED; PG8_LDA(At, 1, 0); PG8_STAGE(PG8_SA(0, 1), a2 + hstepA, voffA);
            PG8_WAIT_V(8); PG8_WAIT_L(0); PG8_BAR; PG8_MMA(0, 0, At, B0); PG8_MMA(0, 1, At, B1); PG8_BAR; PG8_SCHED;
            PG8_LDA(At, 1, 1); PG8_STAGE(PG8_SB(1, 0), b3, voffB); PG8_STAGE(PG8_SB(1, 1), b3 + hstep, voffB); PG8_STAGE(PG8_SA(1, 0), a3, voffA);
            PG8_WAIT_V(8); PG8_WAIT_L(0); PG8_BAR; PG8_MMA(1, 0, At, B0); PG8_MMA(1, 1, At, B1); PG8_BAR; PG8_SCHED;
            } else {
            PG8_LDB(B0, 0, 0); PG8_SCHED; PG8_LDA(At, 0, 0); PG8_STAGE(PG8_SA(1, 1), a1 + hstepA, voffA);
            PG8_WAIT_L(8); PG8_BAR; PG8_WAIT_L(0); PG8_MMA(0, 0, At, B0); PG8_BAR; PG8_SCHED;
            PG8_LDB(B1, 0, 1); PG8_STAGE(PG8_SB(0, 0), b2, voffB);
            PG8_BAR; PG8_WAIT_L(0); PG8_MMA(0, 1, At, B1); PG8_BAR;
            PG8_LDA(At, 0, 1); PG8_STAGE(PG8_SA(0, 0), a2, voffA);
            PG8_BAR; PG8_WAIT_L(0); PG8_MMA(1, 0, At, B0); PG8_BAR; PG8_SCHED;
            PG8_STAGE(PG8_SB(0, 1), b2 + hstep, voffB);
            PG8_WAIT_V(6); PG8_BAR; PG8_MMA(1, 1, At, B1); PG8_BAR;
            PG8_LDB(B0, 1, 0); PG8_SCHED; PG8_LDA(At, 1, 0); PG8_STAGE(PG8_SA(0, 1), a2 + hstepA, voffA);
            PG8_WAIT_L(8); PG8_BAR; PG8_WAIT_L(0); PG8_MMA(0, 0, At, B0); PG8_BAR; PG8_SCHED;
            PG8_LDB(B1, 1, 1); PG8_STAGE(PG8_SB(1, 0), b3, voffB);
            PG8_BAR; PG8_WAIT_L(0); PG8_MMA(0, 1, At, B1); PG8_BAR;
            PG8_LDA(At, 1, 1); PG8_STAGE(PG8_SA(1, 0), a3, voffA);
            PG8_BAR; PG8_WAIT_L(0); PG8_MMA(1, 0, At, B0); PG8_BAR; PG8_SCHED;
            PG8_STAGE(PG8_SB(1, 1), b3 + hstep, voffB);
            PG8_WAIT_V(6); PG8_BAR; PG8_MMA(1, 1, At, B1); PG8_BAR;
            }
        }
        if constexpr (ALIGN_EPI) { if (wr == 0) PG8_BAR; }
        if constexpr (!Epi::AFTER_DRAIN) { E(acc, cur, wr, wc, fr, fq); S.done(cur); }
        if (!has_next) break;
#pragma unroll
        for (int a = 0; a < 2; ++a)
#pragma unroll
            for (int b = 0; b < 2; ++b)
#pragma unroll
                for (int m = 0; m < 4; ++m)
#pragma unroll
                    for (int n = 0; n < 2; ++n) acc[a][b][m][n] = (f32x4){0.f, 0.f, 0.f, 0.f};
        cur = nxt; cA = nA; cB = nB; ++ui;
        if constexpr (ALIGN_EPI) { if (wr == 1) PG8_BAR; }
    }
    PG8_WAIT_V(0);
    if constexpr (!ALIGN_EPI) { if (wr == 0) PG8_BAR; }
    PG8_BAR;
    if constexpr (Epi::AFTER_DRAIN) { E.fused(acc, cur, wr, wc, fr, fq, lds, wid, lane); S.done(cur); }
#undef PG8_SA
#undef PG8_SB
#undef PG8_STAGE
#undef PG8_LDA
#undef PG8_LDB
#undef PG8_MMA
#undef PG8_WAIT_V
#undef PG8_WAIT_L
#undef PG8_BAR
#undef PG8_SCHED
}
}
#define GAS __attribute__((address_space(1)))
#define LAS __attribute__((address_space(3)))
typedef unsigned short bf16;
typedef unsigned v4u __attribute__((ext_vector_type(4)));
typedef float f32x4 __attribute__((ext_vector_type(4)));
typedef short bf16x8 __attribute__((ext_vector_type(8)));
typedef GAS unsigned gu32;
typedef GAS unsigned long long gu64;
#define RLX_AGENT __ATOMIC_RELAXED, __HIP_MEMORY_SCOPE_AGENT
#define LDS_WAIT() asm volatile("s_waitcnt lgkmcnt(0)" ::: "memory")
#define VM_WAIT() asm volatile("s_waitcnt vmcnt(0)" ::: "memory")
__device__ __forceinline__ unsigned long long rt() { return __builtin_amdgcn_s_memrealtime(); }
__device__ __forceinline__ unsigned f2bf(float f) { unsigned u = __builtin_bit_cast(unsigned, f); return (u + 0x7fffu + ((u >> 16) & 1u)) >> 16; }
__device__ __forceinline__ unsigned pk2(float lo, float hi) { return f2bf(lo) | (f2bf(hi) << 16); }

#define XB_TMO      128
#define XB_XCNT(j)  (256  + 64 * (j))
#define XB_XSUB(j)  (1280 + 64 * (j))
#define XB_XGEN(j)  (2304 + 64 * (j))
#define XB_TOP      3328
#define XB_TOPGEN   3392
#define XCD_BAR_WORDS 3456
#define XB_SPIN_CAP (1u << 18)

__device__ __forceinline__ unsigned xb_ld(unsigned* p)              { return __hip_atomic_load(p, __ATOMIC_RELAXED, __HIP_MEMORY_SCOPE_AGENT); }
__device__ __forceinline__ unsigned xb_add(unsigned* p, unsigned v) { return __hip_atomic_fetch_add(p, v, __ATOMIC_RELAXED, __HIP_MEMORY_SCOPE_AGENT); }
__device__ __forceinline__ unsigned xb_xcc_id() { return (unsigned)__builtin_amdgcn_s_getreg((3 << 11) | 20) & 0xFu; }
#define XB_SPIN(cond, bar) do { unsigned _sp = 0; while (cond) { __builtin_amdgcn_s_sleep(1); \
    if ((++_sp & 255u) == 0u) { if (xb_ld(&(bar)[XB_TMO])) break; if (_sp > XB_SPIN_CAP) { atomicAdd(&(bar)[XB_TMO], 1u); break; } } } } while (0)

struct XcdBarrier {
    unsigned* bar; unsigned x;
    volatile LAS unsigned* st;
};

__device__ __forceinline__ XcdBarrier xcd_barrier_post(unsigned* bar, volatile LAS unsigned* st) {
    XcdBarrier b; b.bar = bar; b.x = xb_xcc_id(); b.st = st;
    if (threadIdx.x == 0) (void)xb_add(&bar[XB_XCNT(b.x)], 1u);
    return b;
}
__device__ __forceinline__ void xcd_barrier_complete(unsigned* bar, unsigned x, unsigned& nloc, unsigned& nx) {
    const unsigned G = gridDim.x * gridDim.y * gridDim.z;
    unsigned sum, cnt, mine, sp = 0u;
    for (;;) {
        sum = 0u; cnt = 0u; mine = 0u;
#pragma unroll
        for (unsigned j = 0; j < 16; ++j) { const unsigned c = xb_ld(&bar[XB_XCNT(j)]); sum += c; cnt += (c > 0u) ? 1u : 0u; mine = (j == x) ? c : mine; }
        if (sum == G) break;
        __builtin_amdgcn_s_sleep(1);
        if ((++sp & 255u) == 0u) { if (xb_ld(&bar[XB_TMO])) break; if (sp > XB_SPIN_CAP) { atomicAdd(&bar[XB_TMO], 1u); break; } }
    }
    nloc = mine > 0u ? mine : 1u; nx = cnt > 0u ? cnt : 1u;
}

__device__ __forceinline__ void xcd_barrier(const XcdBarrier& b) {
    asm volatile("s_waitcnt vmcnt(0)" ::: "memory");
    __syncthreads();
    if (threadIdx.x == 0) {
        unsigned* bar = b.bar;
        __builtin_amdgcn_s_waitcnt(0);
        unsigned nloc = b.st[0], nx = b.st[1];
        if (nloc == 0u) { xcd_barrier_complete(bar, b.x, nloc, nx); b.st[0] = nloc; b.st[1] = nx; }
        const unsigned old = xb_add(&bar[XB_XSUB(b.x)], 1u);
        const unsigned gen = old / nloc;
        if (old + 1u == (gen + 1u) * nloc) {
            __builtin_amdgcn_fence(__ATOMIC_RELEASE, "agent");
            asm volatile("s_waitcnt vmcnt(0)" ::: "memory");
            const unsigned og = xb_add(&bar[XB_TOP], 1u);
            const unsigned tg = og / nx;
            if (og + 1u == (tg + 1u) * nx) xb_add(&bar[XB_TOPGEN], 1u);
            else XB_SPIN(xb_ld(&bar[XB_TOPGEN]) == tg, bar);
            __builtin_amdgcn_fence(__ATOMIC_ACQUIRE, "agent");
            xb_add(&bar[XB_XGEN(b.x)], 1u);
            asm volatile("s_waitcnt vmcnt(0)" ::: "memory");
        } else {
            XB_SPIN(xb_ld(&bar[XB_XGEN(b.x)]) == gen, bar);
            __builtin_amdgcn_fence(__ATOMIC_ACQUIRE, "agent");
            asm volatile("s_waitcnt vmcnt(0)" ::: "memory");
        }
    }
    __syncthreads();
}

namespace att {
typedef short bf16x8 __attribute__((ext_vector_type(8)));
typedef short s16x4 __attribute__((ext_vector_type(4)));
typedef float f32x16 __attribute__((ext_vector_type(16)));
typedef unsigned u32x4 __attribute__((ext_vector_type(4)));
typedef LAS char* lptr;
constexpr int NW = 8, QBLK = 32, KVBLK = 64, QB = 256;
constexpr int SHM_V = 16384, SHM_KMAX = 24576;
constexpr int OFF_V = 0, OFF_K = 2 * SHM_V, OFF_WS = OFF_K + 2 * SHM_KMAX, OFF_BIAS = OFF_WS + NW * 64 * 4, ATT_LDS = OFF_BIAS + 1024;
constexpr float THR = 8.f;
#define ATT_SBAR() __builtin_amdgcn_sched_barrier(0)
__device__ __forceinline__ int v_st(int k, int c) { const int kk = (k & ~0xC) | ((k & 4) << 1) | ((k & 8) >> 1); return ((kk >> 3) * 4 + (c >> 5)) * 512 + ((kk & 7) * 32 + (c & 31)) * 2; }
__device__ __forceinline__ int v_rd_base(int lane) { return ((lane & 3) << 3) | (((lane >> 2) & 3) << 6) | (((lane >> 4) & 1) << 5) | (((lane >> 5) & 1) << 8); }
constexpr int v_rd_off(int d0, int ks, int half) { return d0 * 512 + ks * 4096 + half * 2048; }
__device__ __forceinline__ int crow(int r, int hi) { return (r & 3) + 8 * (r >> 2) + 4 * hi; }
__device__ __forceinline__ unsigned cvtpk(float lo, float hi) { unsigned r; asm volatile("v_cvt_pk_bf16_f32 %0, %1, %2" : "=v"(r) : "v"(lo), "v"(hi)); return r; }

__device__ __forceinline__ void partialSM(f32x16& p0, f32x16& p1, float& m_reg, float& mn, float& alpha, float scale, float C2) {
    float pmax = p0[0];
#pragma unroll
    for (int r = 1; r < 16; ++r) pmax = fmaxf(pmax, p0[r]);
#pragma unroll
    for (int r = 0; r < 16; ++r) pmax = fmaxf(pmax, p1[r]);
    { auto rr = __builtin_amdgcn_permlane32_swap(__float_as_uint(pmax), __float_as_uint(pmax), false, false);
      pmax = fmaxf(__uint_as_float(rr[0]), __uint_as_float(rr[1])); }
    if (__builtin_expect(__all((pmax - m_reg) * scale <= THR), 1)) { mn = m_reg; alpha = 1.f; }
    else { mn = fmaxf(m_reg, pmax); alpha = __builtin_amdgcn_exp2f((m_reg - mn) * C2); m_reg = mn; }
    const float mnL = -mn * C2;
#pragma unroll
    for (int r = 0; r < 16; ++r) p0[r] = fmaf(p0[r], C2, mnL);
#pragma unroll
    for (int r = 0; r < 16; ++r) p1[r] = fmaf(p1[r], C2, mnL);
#pragma unroll
    for (int r = 0; r < 16; ++r) p0[r] = __builtin_amdgcn_exp2f(p0[r]);
}
__device__ __forceinline__ void finishSM(f32x16& p0, f32x16& p1, float alpha, float& l_reg, bf16x8& pa0, bf16x8& pa1, bf16x8& pa2, bf16x8& pa3) {
#pragma unroll
    for (int r = 0; r < 16; ++r) p1[r] = __builtin_amdgcn_exp2f(p1[r]);
    float ps = 0;
#pragma unroll
    for (int r = 0; r < 16; ++r) ps += p0[r];
#pragma unroll
    for (int r = 0; r < 16; ++r) ps += p1[r];
    { auto rr = __builtin_amdgcn_permlane32_swap(__float_as_uint(ps), __float_as_uint(ps), false, false);
      ps = __uint_as_float(rr[0]) + __uint_as_float(rr[1]); }
    l_reg = l_reg * alpha + ps;
#define ATT_PK4(P, B_, OUT) do { unsigned a0 = cvtpk(P[B_+0], P[B_+1]), a1 = cvtpk(P[B_+2], P[B_+3]);                          \
        unsigned b0 = cvtpk(P[B_+4], P[B_+5]), b1 = cvtpk(P[B_+6], P[B_+7]);                                             \
        auto r0 = __builtin_amdgcn_permlane32_swap(a0, b0, false, false); auto r1 = __builtin_amdgcn_permlane32_swap(a1, b1, false, false); \
        u32x4 w = {r0[0], r1[0], r0[1], r1[1]}; OUT = __builtin_bit_cast(bf16x8, w); } while (0)
    ATT_PK4(p0, 0, pa0); ATT_PK4(p0, 8, pa1); ATT_PK4(p1, 0, pa2); ATT_PK4(p1, 8, pa3);
#undef ATT_PK4
}
template <int NF, int KP>
__device__ __forceinline__ void qkt(f32x16& p0, f32x16& p1, lptr kbuf, int r32, int hi, const bf16x8* qr) {
    p0 = f32x16{}; p1 = f32x16{};
    lptr kb[4];
#pragma unroll
    for (int dd = 0; dd < 4; ++dd) kb[dd] = kbuf + r32 * KP + (((dd * 16 + hi * 8) * 2) ^ ((r32 & 7) << 4));
#pragma unroll
    for (int d0 = 0; d0 < NF; ++d0) { lptr a = kb[d0 & 3] + (d0 >> 2) * 128;
        const bf16x8 b0 = *(const LAS bf16x8*)a;
        const bf16x8 b1 = *(const LAS bf16x8*)(a + 32 * KP);
        p0 = __builtin_amdgcn_mfma_f32_32x32x16_bf16(b0, qr[d0], p0, 0, 0, 0);
        p1 = __builtin_amdgcn_mfma_f32_32x32x16_bf16(b1, qr[d0], p1, 0, 0, 0); }
}
template <int VB>
__device__ __forceinline__ void pv_tile(f32x16* o, int vb0, bf16x8 pa0, bf16x8 pa1, bf16x8 pa2, bf16x8 pa3) {
#define ATT_TRRD(dst, off) asm volatile("ds_read_b64_tr_b16 %0, %1 offset:%2" : "=&v"(dst) : "v"(vb0), "i"(off) : "memory")
#define ATT_PV_D0(d0) do { s16x4 l0, l1, l2, l3, h0, h1, h2, h3; constexpr int b_ = VB * SHM_V + v_rd_off(d0, 0, 0); \
        ATT_TRRD(l0, b_); ATT_TRRD(h0, b_ + 2048); ATT_TRRD(l1, b_ + 4096); ATT_TRRD(h1, b_ + 6144); ATT_TRRD(l2, b_ + 8192); ATT_TRRD(h2, b_ + 10240); ATT_TRRD(l3, b_ + 12288); ATT_TRRD(h3, b_ + 14336); \
        asm volatile("s_waitcnt lgkmcnt(0)" ::: "memory"); ATT_SBAR();   \
        o[d0] = __builtin_amdgcn_mfma_f32_32x32x16_bf16(pa0, (bf16x8){l0[0], l0[1], l0[2], l0[3], h0[0], h0[1], h0[2], h0[3]}, o[d0], 0, 0, 0);   \
        o[d0] = __builtin_amdgcn_mfma_f32_32x32x16_bf16(pa1, (bf16x8){l1[0], l1[1], l1[2], l1[3], h1[0], h1[1], h1[2], h1[3]}, o[d0], 0, 0, 0);   \
        o[d0] = __builtin_amdgcn_mfma_f32_32x32x16_bf16(pa2, (bf16x8){l2[0], l2[1], l2[2], l2[3], h2[0], h2[1], h2[2], h2[3]}, o[d0], 0, 0, 0);   \
        o[d0] = __builtin_amdgcn_mfma_f32_32x32x16_bf16(pa3, (bf16x8){l3[0], l3[1], l3[2], l3[3], h3[0], h3[1], h3[2], h3[3]}, o[d0], 0, 0, 0); } while (0)
    ATT_PV_D0(0); ATT_PV_D0(1); ATT_PV_D0(2); ATT_PV_D0(3);
#undef ATT_PV_D0
#undef ATT_TRRD
}

struct Blk { const bf16* Q; const bf16* Q2; const bf16* K; const bf16* K2; const bf16* V; void* O; int qp, q2p, kp, k2p, vp, op; int P0, j_lo, j_hi, band; const float* bias; };
template <int DQK, bool BIAS, bool OUTF32>
__device__ __forceinline__ void attn_block(const Blk& B, float scale, lptr lds, int tid) {
    constexpr int NF = DQK / 16, KP = DQK * 2, SHM_K = 64 * KP;
    const int wid = __builtin_amdgcn_readfirstlane(tid >> 6), lane = tid & 63, r32 = lane & 31, hi = lane >> 5;
    lptr V_lds = lds + OFF_V; lptr K_lds = lds + OFF_K;
    LAS float* wsf = (LAS float*)(lds + OFF_WS) + wid * 64; LAS float* li_l = wsf; LAS float* al_l = wsf + 32;
    LAS float* bias_l = (LAS float*)(lds + OFF_BIAS);
    const float C2 = scale * 1.4426950408889634f;
    bf16x8 qr[NF];
    { const bf16* qrow = B.Q + (size_t)(wid * QBLK + r32) * B.qp + hi * 8;
#pragma unroll
      for (int d0 = 0; d0 < 8; ++d0) qr[d0] = *(const GAS bf16x8*)(qrow + d0 * 16);
      if constexpr (DQK == 192) { const bf16* q2row = B.Q2 + (size_t)(wid * QBLK + r32) * B.q2p + hi * 8;
#pragma unroll
          for (int d0 = 0; d0 < 4; ++d0) qr[8 + d0] = *(const GAS bf16x8*)(q2row + d0 * 16); } }
    if constexpr (BIAS) { if (tid < 192) bias_l[tid] = B.bias[tid] / scale; }
    const int sr = tid >> 4, sc = (tid & 15) * 8;
    const int vst0 = v_st(sr, sc), vst1 = v_st(32 + sr, sc);
    const int kws = sr * KP + ((sc * 2) ^ ((sr & 7) << 4));
    const int sr2 = tid >> 3, sc2 = (tid & 7) * 8;
    const int kws2 = sr2 * KP + ((256 + sc2 * 2) ^ ((sr2 & 7) << 4));
    const int vb0 = (int)(unsigned)(uintptr_t)V_lds + v_rd_base(lane);
    const bf16* kg = B.K + (size_t)sr * B.kp + sc; const bf16* vg = B.V + (size_t)sr * B.vp + sc; const bf16* k2g = (DQK == 192) ? B.K2 + (size_t)sr2 * B.k2p + sc2 : nullptr;
    bf16x8 st_k0, st_k1, st_k2, st_v0, st_v1;
#define ATT_SLOAD(k0) do { st_k0 = *(const GAS bf16x8*)(kg + (size_t)(k0) * B.kp); st_k1 = *(const GAS bf16x8*)(kg + (size_t)((k0) + 32) * B.kp); \
                           st_v0 = *(const GAS bf16x8*)(vg + (size_t)(k0) * B.vp); st_v1 = *(const GAS bf16x8*)(vg + (size_t)((k0) + 32) * B.vp); \
                           if constexpr (DQK == 192) st_k2 = *(const GAS bf16x8*)(k2g + (size_t)(k0) * B.k2p); } while (0)
#define ATT_SWRITE(bf) do { *(LAS bf16x8*)(K_lds + (bf) * SHM_K + kws) = st_k0; *(LAS bf16x8*)(K_lds + (bf) * SHM_K + kws + 32 * KP) = st_k1; \
                            *(LAS bf16x8*)(V_lds + (bf) * SHM_V + vst0) = st_v0; *(LAS bf16x8*)(V_lds + (bf) * SHM_V + vst1) = st_v1; \
                            if constexpr (DQK == 192) *(LAS bf16x8*)(K_lds + (bf) * SHM_K + kws2) = st_k2; } while (0)
    const int NT = B.j_hi - B.j_lo;
    const int qlo = B.P0 + wid * QBLK, qc = qlo >> 6;
    float m_reg = -1e30f, l_reg = 0.f; f32x16 o[4] = {};
    f32x16 pA0, pA1; float mnA, alA; bf16x8 pa0, pa1, pa2, pa3;
    ATT_SLOAD(B.j_lo * KVBLK);
    asm volatile("s_waitcnt vmcnt(0)" ::: "memory");
    ATT_SWRITE(0);
    __syncthreads();
#define ATT_STEP(t, BUF) do {                                                                                           \
        if ((t) + 1 < NT) ATT_SLOAD((B.j_lo + (t) + 1) * KVBLK);                                                            \
        ATT_SBAR();                                                                                                         \
        { const int kc = B.j_lo + (t);                                                                                      \
          if (kc <= qc && kc >= qc - B.band) {                                                                              \
            qkt<NF, KP>(pA0, pA1, K_lds + (BUF) * SHM_K, r32, hi, qr);                                                      \
            if constexpr (BIAS) {                                                                                           \
                const int jd = qc - kc;                                                                                     \
                if (jd >= 3) { const float cb = bias_l[191];                                                               \
                    _Pragma("unroll") for (int r = 0; r < 16; ++r) { pA0[r] += cb; pA1[r] += cb; } }                        \
                else { const int base = (qlo + r32) - (kc * KVBLK + 4 * hi) + 63;                                           \
                    _Pragma("unroll") for (int r = 0; r < 16; ++r) { const int i0 = base - ((r & 3) + 8 * (r >> 2)), i1 = i0 - 32; \
                        pA0[r] += bias_l[i0 > 191 ? 191 : i0]; pA1[r] += bias_l[i1 > 191 ? 191 : i1]; } }                   \
            }                                                                                                               \
            partialSM(pA0, pA1, m_reg, mnA, alA, scale, C2);                                                                \
            if (__any(alA < 1.f)) { if (hi == 0) al_l[r32] = alA; asm volatile("s_waitcnt lgkmcnt(0)" ::: "memory");        \
                _Pragma("unroll") for (int d_ = 0; d_ < 4; ++d_) _Pragma("unroll") for (int r = 0; r < 16; ++r) o[d_][r] *= al_l[crow(r, hi)]; } \
            finishSM(pA0, pA1, alA, l_reg, pa0, pa1, pa2, pa3); ATT_SBAR();                                                 \
            pv_tile<BUF>(o, vb0, pa0, pa1, pa2, pa3);                                                                       \
          } }                                                                                                               \
        ATT_SBAR();                                                                                                         \
        if ((t) + 1 < NT) { asm volatile("s_waitcnt vmcnt(0)" ::: "memory"); ATT_SWRITE((BUF) ^ 1); }                       \
        __syncthreads(); } while (0)
    for (int t = 0; t < NT; t += 2) { ATT_STEP(t, 0); ATT_STEP(t + 1, 1); }
    if (hi == 0) li_l[r32] = l_reg;
    asm volatile("s_waitcnt lgkmcnt(0)" ::: "memory");
    float rli[16];
#pragma unroll
    for (int r = 0; r < 16; ++r) rli[r] = __builtin_amdgcn_rcpf(li_l[crow(r, hi)]);
#pragma unroll
    for (int r = 0; r < 16; ++r) { const int orow = wid * QBLK + crow(r, hi);
#pragma unroll
        for (int d0 = 0; d0 < 4; ++d0) { const float v = o[d0][r] * rli[r];
            if constexpr (OUTF32) { ((GAS float*)B.O)[(size_t)orow * B.op + d0 * 32 + r32] = v; }
            else { const float vn = __shfl_xor(v, 1);
                   if ((r32 & 1) == 0) *(GAS unsigned*)((bf16*)B.O + (size_t)orow * B.op + d0 * 32 + r32) = cvtpk(v, vn); } } }
    __syncthreads();
#undef ATT_STEP
#undef ATT_SLOAD
#undef ATT_SWRITE
}
#undef ATT_SBAR
}
#ifndef PROBE_UP
#define PROBE_UP 1
#endif
#ifndef PROBE_DN
#define PROBE_DN 1
#endif
#ifndef PROBE_ATT
#define PROBE_ATT 1
#endif
#ifndef PROBE_BAR
#define PROBE_BAR 1
#endif
#ifndef ATT_A_MFMA
#define ATT_A_MFMA 1
#endif
#ifndef ATT_B_MFMA
#define ATT_B_MFMA 1
#endif
#ifndef ATT_C_MFMA
#define ATT_C_MFMA 1
#endif

constexpr int NWAVES = 8;
constexpr int T = 8192, SEQ = 2048, DM = 2048, FF = 5632, NLAYER = 4, PLE = 256;
constexpr int AB_IN = 3904, AB_INP = 4096, C_IN = 6144, QUP_N = 1536, KVUP_N = 2048;
constexpr float NORM_EPS = 1e-6f;
constexpr size_t MiB = 1u << 20;
constexpr size_t WS_CTL = 0, CTL_ZERO_BYTES = 1 * MiB;
constexpr size_t WS_ROPE = 1 * MiB;
constexpr size_t WS_SSQ = 2 * MiB;
constexpr size_t WS_PB = 4 * MiB;
constexpr size_t WS_W = 20 * MiB;
constexpr size_t W_FFN_IN = WS_W, SZ_FFN_IN = 44 * MiB;
constexpr size_t W_FFN_OUT = W_FFN_IN + 8 * SZ_FFN_IN, SZ_FFN_OUT = 22 * MiB;
constexpr size_t W_AB_IN = W_FFN_OUT + 8 * SZ_FFN_OUT, SZ_AB_IN = 16 * MiB;
constexpr size_t W_QUP = W_AB_IN + 2 * SZ_AB_IN, SZ_QUP = 3 * MiB / 2;
constexpr size_t W_KVUP = W_QUP + 2 * SZ_QUP, SZ_KVUP = 1 * MiB;
constexpr size_t W_AB_OUT = W_KVUP + 2 * SZ_KVUP, SZ_SQ = 8 * MiB;
constexpr size_t W_C_IN = W_AB_OUT + 2 * SZ_SQ, SZ_C_IN = 24 * MiB;
constexpr size_t W_C_OUT = W_C_IN + 2 * SZ_C_IN;
constexpr size_t W_GATE = W_C_OUT + 2 * SZ_SQ;
constexpr size_t W_PROJ = W_GATE + 4 * SZ_SQ, SZ_PROJ = 1 * MiB;
constexpr size_t W_END = W_PROJ + 4 * SZ_PROJ;
constexpr size_t WS_XN = 704 * MiB;
constexpr size_t WS_G = 736 * MiB;
constexpr size_t WS_Y = 824 * MiB;
constexpr size_t WS_U = 888 * MiB;
constexpr size_t WS_QB = 984 * MiB;
constexpr size_t WS_KVB = 1008 * MiB;
constexpr size_t WS_OAT = 1040 * MiB;
constexpr size_t WS_OS = 1072 * MiB;
constexpr size_t WS_PP = 1200 * MiB;
constexpr size_t WS_END = 1264 * MiB;
static_assert(W_END <= WS_XN, "weights overflow");
constexpr int CW_BAR = 4096;

constexpr int RING_OFF = 0, RING_BYTES = 133120;
constexpr int LDSCTL_OFF = RING_BYTES, MISC_OFF = LDSCTL_OFF + 320;
constexpr int LDS_BYTES = 147456;
static_assert(MISC_OFF + 128 <= LDS_BYTES, "LDS map");

struct Frame {
    LAS unsigned char* lds;
    int tid, lane, wave, gw, NGW, G;
};
__device__ __forceinline__ int fresh_tid(Frame& F) { int l_; asm volatile("v_mbcnt_lo_u32_b32 %0, -1, 0\n\tv_mbcnt_hi_u32_b32 %0, -1, %0" : "=v"(l_)); F.lane = l_; F.tid = F.wave * 64 + l_; return F.tid; }
__device__ __forceinline__ float wave_sum(float v) {
#pragma unroll
    for (int o = 1; o < 64; o <<= 1) v += __shfl_xor(v, o);
    return v;
}
__device__ __forceinline__ int il_pair(int r, int half) { return r < half ? 2 * r : 2 * (r - half) + 1; }
__device__ __forceinline__ int wmap(int kind, int n) {
    switch (kind) {
        case 1: { const int r = n >= FF ? 1 : 0, j = n - r * FF; return (j >> 7) * 256 + r * 128 + (j & 127); }
        case 2: return n < 3840 ? n : 3840 + il_pair(n - 3840, 32);
        case 3: { const int h = n / 192, d = n % 192; return d < 128 ? h * 128 + d : 1024 + h * 64 + il_pair(d - 128, 32); }
        case 4: { const int h = n >> 8, d = n & 255; return d < 128 ? h * 128 + d : 1024 + h * 128 + (d - 128); }
        case 5: { const int h = n / 768, r = n % 768; if (r >= 512) return n; const int part = r >> 7, d = r & 127; return h * 768 + part * 128 + (d < 32 ? il_pair(d, 16) : d); }
        default: return n;
    }
}
__device__ __forceinline__ void transpose_load(f32x4 (&v)[16], const float* W, int N, int nblk, int item, int lane) {
    const int kb = item / nblk, nb = item - kb * nblk, k0 = 64 * kb, n0 = 64 * nb;
    const int lr = lane >> 4, lc = (lane & 15) * 4;
#pragma unroll
    for (int i = 0; i < 16; ++i) v[i] = *(const GAS f32x4*)(W + (size_t)(k0 + 4 * i + lr) * N + n0 + lc);
}
__device__ __forceinline__ void transpose_store(f32x4 (&v)[16], int K, int nblk, bf16* WT, int kind, const float* gain, LAS float* scr, int item, int lane) {
    const int kb = item / nblk, nb = item - kb * nblk, k0 = 64 * kb, n0 = 64 * nb;
    const int lr = lane >> 4, lc = (lane & 15) * 4;
    if (gain) {
#pragma unroll
        for (int i = 0; i < 16; ++i) v[i] = v[i] * gain[k0 + 4 * i + lr];
    }
#pragma unroll
    for (int i = 0; i < 16; ++i) { LAS float* d = scr + (4 * i + lr) * 65 + lc; d[0] = v[i].x; d[1] = v[i].y; d[2] = v[i].z; d[3] = v[i].w; }
    LDS_WAIT(); asm volatile("" ::: "memory");
    const int c = lane & 7;
#pragma unroll
    for (int j = 0; j < 8; ++j) { const int n = (lane >> 3) + 8 * j; const LAS float* s = scr + (8 * c) * 65 + n;
        v4u o; o.x = pg8::cvt_pk_bf16(s[0 * 65], s[1 * 65]); o.y = pg8::cvt_pk_bf16(s[2 * 65], s[3 * 65]); o.z = pg8::cvt_pk_bf16(s[4 * 65], s[5 * 65]); o.w = pg8::cvt_pk_bf16(s[6 * 65], s[7 * 65]);
        *(GAS v4u*)(WT + (size_t)wmap(kind, n0 + n) * K + k0 + 8 * c) = o; }
    LDS_WAIT(); asm volatile("" ::: "memory");
}
struct CJob { const float* W; const float* gain; bf16* WT; int K, N, kind; };
__device__ __forceinline__ void norm_pass(const Frame& F, const float* y, const float* hin, float* hout, const float* g_post, float coef, const float* g_pre, bf16* xn) {
    for (int row = F.gw; row < T; row += F.NGW) {
        const GAS f32x4* hr = (const GAS f32x4*)(hin + (size_t)row * DM) + F.lane;
        f32x4 hv[8];
#pragma unroll
        for (int j = 0; j < 8; ++j) hv[j] = hr[64 * j];
        if (y) {
            const GAS f32x4* yr = (const GAS f32x4*)(y + (size_t)row * DM) + F.lane;
            f32x4 yv[8]; float s = 0.f;
#pragma unroll
            for (int j = 0; j < 8; ++j) { yv[j] = yr[64 * j]; s += (yv[j].x * yv[j].x + yv[j].y * yv[j].y) + (yv[j].z * yv[j].z + yv[j].w * yv[j].w); }
            const float rstd = coef / sqrtf(wave_sum(s) * (1.f / DM) + NORM_EPS);
#pragma unroll
            for (int j = 0; j < 8; ++j) { const f32x4 g = *((const GAS f32x4*)g_post + F.lane + 64 * j); hv[j] = hv[j] + yv[j] * rstd * g; }
        }
        GAS f32x4* ho = (GAS f32x4*)(hout + (size_t)row * DM) + F.lane;
#pragma unroll
        for (int j = 0; j < 8; ++j) ho[64 * j] = hv[j];
        if (g_pre) {
            float s2 = 0.f;
#pragma unroll
            for (int j = 0; j < 8; ++j) s2 += (hv[j].x * hv[j].x + hv[j].y * hv[j].y) + (hv[j].z * hv[j].z + hv[j].w * hv[j].w);
            const float rstd2 = 1.f / sqrtf(wave_sum(s2) * (1.f / DM) + NORM_EPS);
            GAS unsigned long long* o8 = (GAS unsigned long long*)(xn + (size_t)row * DM) + F.lane;
#pragma unroll
            for (int j = 0; j < 8; ++j) { const f32x4 g = *((const GAS f32x4*)g_pre + F.lane + 64 * j); const f32x4 v = hv[j] * rstd2 * g;
                o8[64 * j] = (unsigned long long)pg8::cvt_pk_bf16(v.x, v.y) | ((unsigned long long)pg8::cvt_pk_bf16(v.z, v.w) << 32); }
        }
    }
}

typedef __bf16 bf16x2_t __attribute__((ext_vector_type(2)));
__device__ __forceinline__ float dot2bf(unsigned a, unsigned b, float c) { return __builtin_amdgcn_fdot2_f32_bf16(__builtin_bit_cast(bf16x2_t, a), __builtin_bit_cast(bf16x2_t, b), c, false); }
template <int DQK, bool BIAS, int VC>
__device__ __forceinline__ void sattn_wave(const bf16* qa, const bf16* qb, const bf16* ka, size_t pka, const bf16* kb, size_t pkb, const bf16* v, size_t pv,
                                           int j0, int j1, float sc2, const float* bias2  , int qpos, int kpos0, float (&acc)[VC]) {
    constexpr int NQ = DQK / 2;
    unsigned qp[NQ];
#pragma unroll
    for (int c = 0; c < 16; ++c) { const v4u w = *(const GAS v4u*)(qa + 8 * c); qp[4 * c] = w.x; qp[4 * c + 1] = w.y; qp[4 * c + 2] = w.z; qp[4 * c + 3] = w.w; }
    if constexpr (DQK == 192) {
#pragma unroll
        for (int c = 0; c < 8; ++c) { const v4u w = *(const GAS v4u*)(qb + 8 * c); qp[64 + 4 * c] = w.x; qp[64 + 4 * c + 1] = w.y; qp[64 + 4 * c + 2] = w.z; qp[64 + 4 * c + 3] = w.w; }
    }
#pragma unroll
    for (int c = 0; c < VC; ++c) acc[c] = 0.f;
    float m = -1e30f, l = 0.f;
#pragma unroll 1
    for (int j = j0; j < j1; ++j) {
        const GAS v4u* kr = (const GAS v4u*)(ka + (size_t)j * pka);
        float d0 = 0.f, d1 = 0.f;
#pragma unroll
        for (int c = 0; c < 16; ++c) { const v4u w = kr[c]; d0 = dot2bf(w.x, qp[4 * c], d0); d1 = dot2bf(w.y, qp[4 * c + 1], d1); d0 = dot2bf(w.z, qp[4 * c + 2], d0); d1 = dot2bf(w.w, qp[4 * c + 3], d1); }
        if constexpr (DQK == 192) {
            const GAS v4u* kr2 = (const GAS v4u*)(kb + (size_t)j * pkb);
#pragma unroll
            for (int c = 0; c < 8; ++c) { const v4u w = kr2[c]; d0 = dot2bf(w.x, qp[64 + 4 * c], d0); d1 = dot2bf(w.y, qp[64 + 4 * c + 1], d1); d0 = dot2bf(w.z, qp[64 + 4 * c + 2], d0); d1 = dot2bf(w.w, qp[64 + 4 * c + 3], d1); }
        }
        float sv = (d0 + d1) * sc2;
        if constexpr (BIAS) { int dist = qpos - (kpos0 + (j - j0)); dist = dist < -63 ? -63 : (dist > 128 ? 128 : dist); sv += bias2[dist + 63]; }
        const float mn = fmaxf(m, sv), alpha = __builtin_amdgcn_exp2f(m - mn), pw = __builtin_amdgcn_exp2f(sv - mn);
        m = mn; l = l * alpha + pw;
        const GAS v4u* vr = (const GAS v4u*)(v + (size_t)j * pv);
#pragma unroll
        for (int c = 0; c < VC / 8; ++c) { const v4u w = vr[c];
            acc[8 * c + 0] = acc[8 * c + 0] * alpha + pw * __uint_as_float(w.x << 16); acc[8 * c + 1] = acc[8 * c + 1] * alpha + pw * __uint_as_float(w.x & 0xffff0000u);
            acc[8 * c + 2] = acc[8 * c + 2] * alpha + pw * __uint_as_float(w.y << 16); acc[8 * c + 3] = acc[8 * c + 3] * alpha + pw * __uint_as_float(w.y & 0xffff0000u);
            acc[8 * c + 4] = acc[8 * c + 4] * alpha + pw * __uint_as_float(w.z << 16); acc[8 * c + 5] = acc[8 * c + 5] * alpha + pw * __uint_as_float(w.z & 0xffff0000u);
            acc[8 * c + 6] = acc[8 * c + 6] * alpha + pw * __uint_as_float(w.w << 16); acc[8 * c + 7] = acc[8 * c + 7] * alpha + pw * __uint_as_float(w.w & 0xffff0000u); }
    }
    const float rl = 1.0f / l;
#pragma unroll
    for (int c = 0; c < VC; ++c) acc[c] *= rl;
}
template <int VC> __device__ __forceinline__ void storeN_bf16(bf16* o, const float (&acc)[VC]) {
#pragma unroll
    for (int c = 0; c < VC / 8; ++c) { v4u w; w.x = pg8::cvt_pk_bf16(acc[8 * c], acc[8 * c + 1]); w.y = pg8::cvt_pk_bf16(acc[8 * c + 2], acc[8 * c + 3]); w.z = pg8::cvt_pk_bf16(acc[8 * c + 4], acc[8 * c + 5]); w.w = pg8::cvt_pk_bf16(acc[8 * c + 6], acc[8 * c + 7]);
        *(GAS v4u*)(o + 8 * c) = w; }
}
__device__ __forceinline__ void store64_f32(float* o, const float (&acc)[64]) {
#pragma unroll
    for (int c = 0; c < 16; ++c) *(GAS f32x4*)(o + 4 * c) = (f32x4){acc[4 * c], acc[4 * c + 1], acc[4 * c + 2], acc[4 * c + 3]};
}
constexpr float LOG2E = 1.4426950408889634f;
__device__ __forceinline__ void attn_even_simple(const Frame& F, const bf16* U, const bf16* QB, const bf16* KVB, bf16* OAT, const float* bias2  ) {
#if !ATT_A_MFMA
    for (int u = F.gw; u < 2048; u += F.NGW) {
        float acc[64];
        const int n = u & 31, r = u >> 5, slice = r & 1, h = (r >> 1) & 7, b = r >> 4;
        const int row = b * SEQ + n * 64 + F.lane, nlo = n >= 8 ? n - 8 : 0;
        sattn_wave<128, true, 64>(U + (size_t)row * AB_INP + h * 128, nullptr, U + 1024 + h * 128, AB_INP, nullptr, 0, U + 2048 + h * 128 + slice * 64, AB_INP,
                                  b * SEQ + nlo * 64, b * SEQ + (n + 1) * 64, 0.08838834764831845f * LOG2E, bias2 + h * 192, n * 64 + F.lane, nlo * 64, acc);
        storeN_bf16<64>(OAT + (size_t)row * DM + h * 128 + slice * 64, acc);
    }
#endif
#if !ATT_B_MFMA
    for (int u = F.gw; u < 4096; u += F.NGW) {
        float acc[32];
        const int k = u >> 11, w = u & 2047, nb = w & 31, n = k ? 31 - nb : nb, r = (w >> 5) + 64 * k, slice = r & 3, h = (r >> 2) & 7, b = r >> 5;
        const int row = b * SEQ + n * 64 + F.lane;
        sattn_wave<192, false, 32>(QB + (size_t)row * QUP_N + h * 128, QB + (size_t)row * QUP_N + 1024 + h * 64, KVB + h * 128, KVUP_N, U + 3840, AB_INP, KVB + 1024 + h * 128 + slice * 32, KVUP_N,
                                   b * SEQ, b * SEQ + (n + 1) * 64, 0.07216878364870322f * LOG2E, nullptr, 0, 0, acc);
        storeN_bf16<32>(OAT + (size_t)row * DM + 1024 + h * 128 + slice * 32, acc);
    }
#endif
}
__device__ __forceinline__ void attn_odd_simple(const Frame& F, const bf16* U, float* OS) {
    float acc[64];
    for (int u = F.gw; u < 8192; u += F.NGW) {
        const int k = u >> 11, w = u & 2047, nb = w & 31, n = (k & 1) ? 31 - nb : nb, r = (w >> 5) + 64 * k, slice = r & 3, s = (r >> 2) & 1, h = (r >> 3) & 7, b = r >> 6;
        const int row = b * SEQ + n * 64 + F.lane;
        sattn_wave<128, false, 64>(U + (size_t)row * C_IN + h * 768 + s * 128, nullptr, U + h * 768 + 256 + s * 128, C_IN, nullptr, 0, U + h * 768 + 512 + slice * 64, C_IN,
                               b * SEQ, b * SEQ + (n + 1) * 64, 0.08838834764831845f * LOG2E, nullptr, 0, 0, acc);
        store64_f32(OS + (size_t)s * T * DM + (size_t)row * DM + h * 256 + slice * 64, acc);
    }
}
__device__ __forceinline__ void attn_even_mfma(const Frame& F, const bf16* U, const bf16* QB, const bf16* KVB, bf16* OAT, const float* relbias  ) {
    att::lptr lds = (att::lptr)(F.lds + RING_OFF);
    for (int it = blockIdx.x; it < 256; it += F.G) {
        const int qbB = it & 7, h = (it >> 3) & 7, b = it >> 6, qbA = 7 - qbB;
#if ATT_B_MFMA
        { att::Blk B; const size_t r0 = (size_t)b * SEQ + qbB * 256, k0 = (size_t)b * SEQ;
          B.Q = QB + r0 * QUP_N + h * 128; B.Q2 = QB + r0 * QUP_N + 1024 + h * 64; B.K = KVB + k0 * KVUP_N + h * 128; B.K2 = U + k0 * AB_INP + 3840; B.V = KVB + k0 * KVUP_N + 1024 + h * 128;
          B.O = OAT + r0 * DM + 1024 + h * 128; B.qp = QUP_N; B.q2p = QUP_N; B.kp = KVUP_N; B.k2p = AB_INP; B.vp = KVUP_N; B.op = DM; B.P0 = qbB * 256; B.j_lo = 0; B.j_hi = 4 * qbB + 4; B.band = 1 << 20; B.bias = nullptr;
          att::attn_block<192, false, false>(B, 0.07216878364870322f, lds, F.tid); }
#endif
#if ATT_A_MFMA
        { att::Blk B; const size_t r0 = (size_t)b * SEQ + qbA * 256, k0 = (size_t)b * SEQ;
          B.Q = U + r0 * AB_INP + h * 128; B.Q2 = nullptr; B.K = U + k0 * AB_INP + 1024 + h * 128; B.K2 = nullptr; B.V = U + k0 * AB_INP + 2048 + h * 128;
          B.O = OAT + r0 * DM + h * 128; B.qp = AB_INP; B.q2p = 0; B.kp = AB_INP; B.k2p = 0; B.vp = AB_INP; B.op = DM; B.P0 = qbA * 256; B.j_lo = qbA >= 2 ? 4 * qbA - 8 : 0; B.j_hi = 4 * qbA + 4; B.band = 8; B.bias = relbias + h * 192;
          att::attn_block<128, true, false>(B, 0.08838834764831845f, lds, F.tid); }
#endif
    }
}
__device__ __forceinline__ void attn_odd_mfma(const Frame& F, const bf16* U, float* OS) {
    att::lptr lds = (att::lptr)(F.lds + RING_OFF);
    for (int it = blockIdx.x; it < 512; it += F.G) {
        const int x = it & 3, r = it >> 2, vh = r & 1, s = (r >> 1) & 1, h = (r >> 2) & 7, b = r >> 5;
        for (int pass = 0; pass < 2; ++pass) {
            const int qb = pass ? x : 7 - x;
            att::Blk B; const size_t r0 = (size_t)b * SEQ + qb * 256, k0 = (size_t)b * SEQ;
            B.Q = U + r0 * C_IN + h * 768 + s * 128; B.Q2 = nullptr; B.K = U + k0 * C_IN + h * 768 + 256 + s * 128; B.K2 = nullptr; B.V = U + k0 * C_IN + h * 768 + 512 + vh * 128;
            B.O = OS + (size_t)s * T * DM + r0 * DM + h * 256 + vh * 128; B.qp = C_IN; B.q2p = 0; B.kp = C_IN; B.k2p = 0; B.vp = C_IN; B.op = DM; B.P0 = qb * 256; B.j_lo = 0; B.j_hi = 4 * qb + 4; B.band = 1 << 20; B.bias = nullptr;
            att::attn_block<128, false, true>(B, 0.08838834764831845f, lds, F.tid);
        }
    }
}
__device__ __forceinline__ void csub_pass(const Frame& F, const float* OS, bf16* OAT, const float* lq1, const float* lk1, const float* lq2, const float* lk2, const float* g_sub, int layer) {
    asm volatile("" : "+s"(layer));
    const float lambda_init = 0.8f - 0.6f * expf(-0.3f * (float)layer);
    const float d1 = wave_sum(lq1[F.lane] * lk1[F.lane] + lq1[F.lane + 64] * lk1[F.lane + 64]);
    const float d2 = wave_sum(lq2[F.lane] * lk2[F.lane] + lq2[F.lane + 64] * lk2[F.lane + 64]);
    const float lam = expf(d1) - expf(d2) + lambda_init, post = 1.0f - lambda_init;
    const f32x4 g = *((const GAS f32x4*)g_sub + F.lane);
    for (int row = F.gw; row < T; row += F.NGW) {
#pragma unroll
        for (int h = 0; h < 8; ++h) {
            const f32x4 o1 = *((const GAS f32x4*)(OS + (size_t)row * DM + h * 256) + F.lane), o2 = *((const GAS f32x4*)(OS + (size_t)T * DM + (size_t)row * DM + h * 256) + F.lane);
            const f32x4 d = o1 - o2 * lam;
            const float ss = wave_sum((d.x * d.x + d.y * d.y) + (d.z * d.z + d.w * d.w));
            const float rstd = post / sqrtf(ss * (1.f / 256.f) + NORM_EPS);
            const f32x4 o = d * rstd * g;
            *((GAS unsigned long long*)(OAT + (size_t)row * DM + h * 256) + F.lane) = (unsigned long long)pg8::cvt_pk_bf16(o.x, o.y) | ((unsigned long long)pg8::cvt_pk_bf16(o.z, o.w) << 32);
        }
    }
}

struct Args { const float* in[30]; float* out; unsigned char* ws; };
enum { IN_X = 0, IN_P, IN_F1_GPRE, IN_F1_WIN, IN_F1_WOUT, IN_F1_GPOST, IN_MIX_GPRE, IN_MIX_GPOST, IN_AB_WIN, IN_A_BIAS, IN_B_GQ, IN_B_WQUP, IN_B_GKV, IN_B_WKVUP, IN_AB_WOUT,
       IN_C_WIN, IN_C_LQ1, IN_C_LK1, IN_C_LQ2, IN_C_LK2, IN_C_GSUB, IN_C_WOUT, IN_F2_GPRE, IN_F2_WIN, IN_F2_WOUT, IN_F2_GPOST, IN_PLE_GPRE, IN_PLE_WGATE, IN_PLE_WPROJ, IN_PLE_GPOST };

__device__ __forceinline__ bool conv_job(const Args& args, unsigned char* ws, int l, int seg, int k, CJob& J) {
    const int j = l >> 1; const bool even = (l & 1) == 0;
    J.gain = nullptr; J.kind = 0;
    if (seg == 0) {
        if (k == 0) { J.W = args.in[IN_F1_WIN] + (size_t)l * DM * 2 * FF; J.K = DM; J.N = 2 * FF; J.WT = (bf16*)(ws + W_FFN_IN + (size_t)l * SZ_FFN_IN); J.kind = 1; return true; }
        if (k == 1) { J.W = args.in[IN_F1_WOUT] + (size_t)l * FF * DM; J.K = FF; J.N = DM; J.WT = (bf16*)(ws + W_FFN_OUT + (size_t)l * SZ_FFN_OUT); return true; }
        if (k == 2) { if (even) { J.W = args.in[IN_AB_WIN] + (size_t)j * DM * AB_IN; J.K = DM; J.N = AB_IN; J.WT = (bf16*)(ws + W_AB_IN + (size_t)j * SZ_AB_IN); J.kind = 2; }
                      else { J.W = args.in[IN_C_WIN] + (size_t)j * DM * C_IN; J.K = DM; J.N = C_IN; J.WT = (bf16*)(ws + W_C_IN + (size_t)j * SZ_C_IN); J.kind = 5; } return true; }
        if (k == 3 && even) { J.W = args.in[IN_B_WQUP] + (size_t)j * 512 * QUP_N; J.K = 512; J.N = QUP_N; J.WT = (bf16*)(ws + W_QUP + (size_t)j * SZ_QUP); J.kind = 3; J.gain = args.in[IN_B_GQ] + j * 512; return true; }
        if (k == 4 && even) { J.W = args.in[IN_B_WKVUP] + (size_t)j * 256 * KVUP_N; J.K = 256; J.N = KVUP_N; J.WT = (bf16*)(ws + W_KVUP + (size_t)j * SZ_KVUP); J.kind = 4; J.gain = args.in[IN_B_GKV] + j * 256; return true; }
        return false;
    }
    if (k == 0) { J.W = args.in[even ? IN_AB_WOUT : IN_C_WOUT] + (size_t)j * DM * DM; J.K = DM; J.N = DM; J.WT = (bf16*)(ws + (even ? W_AB_OUT : W_C_OUT) + (size_t)j * SZ_SQ); return true; }
    if (k == 1) { J.W = args.in[IN_F2_WIN] + (size_t)l * DM * 2 * FF; J.K = DM; J.N = 2 * FF; J.WT = (bf16*)(ws + W_FFN_IN + (size_t)(4 + l) * SZ_FFN_IN); J.kind = 1; return true; }
    if (k == 2) { J.W = args.in[IN_F2_WOUT] + (size_t)l * FF * DM; J.K = FF; J.N = DM; J.WT = (bf16*)(ws + W_FFN_OUT + (size_t)(4 + l) * SZ_FFN_OUT); return true; }
    if (k == 3) { J.W = args.in[IN_PLE_WGATE] + (size_t)l * DM * DM; J.K = DM; J.N = DM; J.WT = (bf16*)(ws + W_GATE + (size_t)l * SZ_SQ); return true; }
    if (k == 4) { J.W = args.in[IN_PLE_WPROJ] + (size_t)l * PLE * DM; J.K = PLE; J.N = DM; J.WT = (bf16*)(ws + W_PROJ + (size_t)l * SZ_PROJ); return true; }
    return false;
}
__device__ __forceinline__ void convert_seg(const Frame& F, const Args& args, unsigned char* ws, int l, int seg, int worker, int nworkers, int part, int nparts) {
    LAS float* scr = (LAS float*)(F.lds + RING_OFF + F.wave * 16640);
    int total = 0;
#pragma unroll 1
    for (int k = 0; k < 5; ++k) { CJob J; if (conv_job(args, ws, l, seg, k, J)) total += (J.K >> 6) * (J.N >> 6); }
    const int lo = (int)((long)total * part / nparts), hi = (int)((long)total * (part + 1) / nparts);
    int base = 0;
#pragma unroll 1
    for (int k = 0; k < 5; ++k) {
        CJob J; if (!conv_job(args, ws, l, seg, k, J)) continue;
        const int n = (J.K >> 6) * (J.N >> 6), a = lo > base ? lo - base : 0, b = hi - base < n ? hi - base : n, nblk = J.N >> 6;
        if (a < b) {
            int it = a + (worker - ((a + base) % nworkers) + nworkers) % nworkers;
            if (it < b) {
                f32x4 va[16], vb[16];
                transpose_load(va, J.W, J.N, nblk, it, F.lane);
                for (;;) {
                    const int it1 = it + nworkers; const bool h1 = it1 < b;
                    transpose_load(vb, J.W, J.N, nblk, h1 ? it1 : it, F.lane);
                    transpose_store(va, J.K, nblk, J.WT, J.kind, J.gain, scr, it, F.lane);
                    if (!h1) break;
                    const int it2 = it1 + nworkers; const bool h2 = it2 < b;
                    transpose_load(va, J.W, J.N, nblk, h2 ? it2 : it1, F.lane);
                    transpose_store(vb, J.K, nblk, J.WT, J.kind, J.gain, scr, it1, F.lane);
                    if (!h2) break;
                    it = it2;
                }
            }
        }
        base += n;
    }
}

__global__ void __launch_bounds__(NWAVES * 64, 2) fwd_kernel(Args args) {
    extern __shared__ __attribute__((aligned(16))) unsigned char lds[];
    Frame F;
    F.lds = (LAS unsigned char*)lds;
    volatile LAS unsigned* MISC = (volatile LAS unsigned*)(F.lds + MISC_OFF);
    F.tid = threadIdx.x; F.lane = F.tid & 63; F.wave = __builtin_amdgcn_readfirstlane(F.tid >> 6);
    F.G = gridDim.x; F.gw = blockIdx.x * NWAVES + F.wave; F.NGW = F.G * NWAVES;
    unsigned char* ws = args.ws;
    gu32* ctl = (gu32*)(ws + WS_CTL);
    for (int u = F.tid; u < (LDS_BYTES - LDSCTL_OFF) / 4; u += NWAVES * 64) ((LAS unsigned*)(F.lds + LDSCTL_OFF))[u] = 0u;
    __syncthreads();
    XcdBarrier bar = xcd_barrier_post((unsigned*)(ctl + CW_BAR), MISC + 8);
#define GRID_BAR() do { for (int brep_ = 0; brep_ < PROBE_BAR; ++brep_) { XcdBarrier b_ = bar; asm volatile("" : "+s"(b_.bar), "+s"(b_.x)); xcd_barrier(b_); } } while (0)
#define PHASE() (void)fresh_tid(F)

    float* const h = args.out;
    float* cosB = (float*)(ws + WS_ROPE); float* sinB = cosB + 2048 * 32; float* cosC = sinB + 2048 * 32; float* sinC = cosC + 2048 * 16;
    float* bias2 = sinC + 2048 * 16;
    float* SSQ = (float*)(ws + WS_SSQ);
    bf16* PB = (bf16*)(ws + WS_PB);
    bf16* XN = (bf16*)(ws + WS_XN); bf16* Gb = (bf16*)(ws + WS_G); float* Y = (float*)(ws + WS_Y); bf16* U = (bf16*)(ws + WS_U);
    bf16* QB = (bf16*)(ws + WS_QB); bf16* KVB = (bf16*)(ws + WS_KVB); bf16* OAT = (bf16*)(ws + WS_OAT); float* OS = (float*)(ws + WS_OS); float* PP = (float*)(ws + WS_PP);

    {
        PHASE();
        convert_seg(F, args, ws, 0, 0, F.gw, F.NGW, 0, 1);
        for (int j = 0; j < 2; ++j) {
            GAS v4u* z = (GAS v4u*)(ws + W_AB_IN + (size_t)j * SZ_AB_IN + (size_t)AB_IN * DM * 2); const int nz = (AB_INP - AB_IN) * DM * 2 / 16;
            for (int i = blockIdx.x * (NWAVES * 64) + F.tid; i < nz; i += F.G * NWAVES * 64) z[i] = (v4u){0u, 0u, 0u, 0u}; }
        for (int i = blockIdx.x * (NWAVES * 64) + F.tid; i < 2048 * 32; i += F.G * NWAVES * 64) { const int pos = i >> 5, f = i & 31; const float inv = powf(500000.0f, -(float)(2 * f) / 64.0f), ang = (float)pos * inv; cosB[i] = cosf(ang); sinB[i] = sinf(ang); }
        for (int i = blockIdx.x * (NWAVES * 64) + F.tid; i < 2048 * 16; i += F.G * NWAVES * 64) { const int pos = i >> 4, f = i & 15; const float inv = powf(500000.0f, -(float)(2 * f) / 32.0f), ang = (float)pos * inv; cosC[i] = cosf(ang); sinC[i] = sinf(ang); }
        { const GAS f32x4* src = (const GAS f32x4*)args.in[IN_P]; GAS unsigned long long* dst = (GAS unsigned long long*)PB; const int n4 = NLAYER * T * PLE / 4;
          for (int i = blockIdx.x * (NWAVES * 64) + F.tid; i < n4; i += F.G * NWAVES * 64) { const f32x4 v = src[i]; dst[i] = (unsigned long long)pg8::cvt_pk_bf16(v.x, v.y) | ((unsigned long long)pg8::cvt_pk_bf16(v.z, v.w) << 32); } }
        norm_pass(F, nullptr, args.in[IN_X], h, nullptr, 0.f, args.in[IN_F1_GPRE], XN);
    }
    GRID_BAR();

    for (int i = 0; i < NLAYER; ++i) {
        const int j = i >> 1; const bool even = (i & 1) == 0;
        for (int half = 0; half < 2; ++half) {
            { pg8::Gemm g{XN, (const bf16*)(ws + W_FFN_IN + (size_t)(half * 4 + i) * SZ_FFN_IN), T, 2 * FF, DM, DM}; pg8::StaticOrder S; S.init(T, 2 * FF, F.G, (int)blockIdx.x);
              pg8::EpiSwiglu E{Gb, FF};
              for (int rep_ = 0; rep_ < PROBE_UP; ++rep_) pg8::gemm_phase<pg8::EpiSwiglu, pg8::StaticOrder, true, true>(F.lds + RING_OFF, g, S, E, fresh_tid(F)); }
            { const int nunits = (T / 256) * (2 * FF / 256), rem = nunits % F.G, c0 = rem;
              if ((int)blockIdx.x >= c0) {
                  PHASE();
                  const int nwg = F.G - c0, worker = ((int)blockIdx.x - c0) * NWAVES + F.wave, nworkers = nwg * NWAVES;
                  if (half == 1) {
                      pg8::Gemm g{PB + (size_t)i * T * PLE, (const bf16*)(ws + W_PROJ + (size_t)i * SZ_PROJ), T, DM, PLE, PLE}; pg8::StaticOrder S; S.init(T, DM, nwg, (int)blockIdx.x - c0);
                      pg8::EpiF32 E{PP, DM};
                      pg8::gemm_phase<pg8::EpiF32, pg8::StaticOrder, true, true>(F.lds + RING_OFF, g, S, E, fresh_tid(F));
                      PHASE();
                  }
                  if (half == 0) convert_seg(F, args, ws, i, 1, worker, nworkers, 0, 1);
                  else if (i + 1 < NLAYER) convert_seg(F, args, ws, i + 1, 0, worker, nworkers, 0, 1);
              } }
            GRID_BAR();
            { pg8::Gemm g{Gb, (const bf16*)(ws + W_FFN_OUT + (size_t)(half * 4 + i) * SZ_FFN_OUT), T, DM, FF, FF}; pg8::StaticOrder S; S.init(T, DM, F.G, (int)blockIdx.x);
              pg8::EpiF32 E{Y, DM};
              for (int rep_ = 0; rep_ < PROBE_DN; ++rep_) pg8::gemm_phase<pg8::EpiF32, pg8::StaticOrder, true, true>(F.lds + RING_OFF, g, S, E, fresh_tid(F)); }
            GRID_BAR();
            PHASE();
            norm_pass(F, Y, h, h, args.in[half == 0 ? IN_F1_GPOST : IN_F2_GPOST] + i * DM, 0.5f, args.in[half == 0 ? IN_MIX_GPRE : IN_PLE_GPRE] + i * DM, XN);
            GRID_BAR();
            if (half == 0) {
                if (even) {
                    { pg8::Gemm g{XN, (const bf16*)(ws + W_AB_IN + (size_t)j * SZ_AB_IN), T, AB_INP, DM, DM}; pg8::StaticOrder S; S.init(T, AB_INP, F.G, (int)blockIdx.x);
                      pg8::EpiBf<0> E{U, AB_INP, SSQ, cosB, sinB, NORM_EPS};
                      pg8::gemm_phase<pg8::EpiBf<0>, pg8::StaticOrder, true, true>(F.lds + RING_OFF, g, S, E, fresh_tid(F)); }
                    PHASE();
                    if (F.gw == 0) { for (int t = F.lane; t < 8 * 192; t += 64) bias2[t] = args.in[IN_A_BIAS][j * 8 * 192 + t] * LOG2E; }
                    GRID_BAR();
                    { pg8::Gemm g{U + 3072, (const bf16*)(ws + W_QUP + (size_t)j * SZ_QUP), T, QUP_N, 512, AB_INP}; pg8::StaticOrder S; S.init(T, QUP_N, F.G, (int)blockIdx.x);
                      pg8::EpiBf<1> E{QB, QUP_N, SSQ, cosB, sinB, NORM_EPS};
                      pg8::gemm_phase<pg8::EpiBf<1>, pg8::StaticOrder, true, true>(F.lds + RING_OFF, g, S, E, fresh_tid(F)); }
                    { pg8::Gemm g{U + 3584, (const bf16*)(ws + W_KVUP + (size_t)j * SZ_KVUP), T, KVUP_N, 256, AB_INP}; pg8::StaticOrder S; S.init(T, KVUP_N, F.G, (int)blockIdx.x);
                      pg8::EpiBf<2> E{KVB, KVUP_N, SSQ, cosB, sinB, NORM_EPS};
                      pg8::gemm_phase<pg8::EpiBf<2>, pg8::StaticOrder, true, true>(F.lds + RING_OFF, g, S, E, fresh_tid(F)); }
                    GRID_BAR();
                    PHASE();
#if ATT_A_MFMA || ATT_B_MFMA
                    for (int rep_ = 0; rep_ < PROBE_ATT; ++rep_) attn_even_mfma(F, U, QB, KVB, OAT, args.in[IN_A_BIAS] + j * 8 * 192);
#endif
#if !(ATT_A_MFMA && ATT_B_MFMA)
                    attn_even_simple(F, U, QB, KVB, OAT, bias2);
#endif
                    GRID_BAR();
                } else {
                    { pg8::Gemm g{XN, (const bf16*)(ws + W_C_IN + (size_t)j * SZ_C_IN), T, C_IN, DM, DM}; pg8::StaticOrder S; S.init(T, C_IN, F.G, (int)blockIdx.x);
                      pg8::EpiBf<3> E{U, C_IN, SSQ, cosC, sinC, NORM_EPS};
                      pg8::gemm_phase<pg8::EpiBf<3>, pg8::StaticOrder, true, true>(F.lds + RING_OFF, g, S, E, fresh_tid(F)); }
                    GRID_BAR();
                    PHASE();
#if ATT_C_MFMA
                    for (int rep_ = 0; rep_ < PROBE_ATT; ++rep_) attn_odd_mfma(F, U, OS);
#else
                    attn_odd_simple(F, U, OS);
#endif
                    GRID_BAR();
                    PHASE();
                    csub_pass(F, OS, OAT, args.in[IN_C_LQ1] + j * 128, args.in[IN_C_LK1] + j * 128, args.in[IN_C_LQ2] + j * 128, args.in[IN_C_LK2] + j * 128, args.in[IN_C_GSUB] + j * 256, i);
                    GRID_BAR();
                }
                { pg8::Gemm g{OAT, (const bf16*)(ws + (even ? W_AB_OUT : W_C_OUT) + (size_t)j * SZ_SQ), T, DM, DM, DM}; pg8::StaticOrder S; S.init(T, DM, F.G, (int)blockIdx.x);
                  pg8::EpiF32 E{Y, DM};
                  pg8::gemm_phase<pg8::EpiF32, pg8::StaticOrder, true, true>(F.lds + RING_OFF, g, S, E, fresh_tid(F)); }
                GRID_BAR();
                PHASE();
                norm_pass(F, Y, h, h, args.in[IN_MIX_GPOST] + i * DM, 1.0f, args.in[IN_F2_GPRE] + i * DM, XN);
                GRID_BAR();
            } else {
                { pg8::Gemm g{XN, (const bf16*)(ws + W_GATE + (size_t)i * SZ_SQ), T, DM, DM, DM}; pg8::StaticOrder S; S.init(T, DM, F.G, (int)blockIdx.x);
                  pg8::EpiGate E{Y, PP, DM};
                  pg8::gemm_phase<pg8::EpiGate, pg8::StaticOrder, true, true>(F.lds + RING_OFF, g, S, E, fresh_tid(F)); }
                GRID_BAR();
                PHASE();
                norm_pass(F, Y, h, h, args.in[IN_PLE_GPOST] + i * DM, 1.0f, i + 1 < NLAYER ? args.in[IN_F1_GPRE] + (i + 1) * DM : nullptr, XN);
                if (i + 1 < NLAYER) GRID_BAR();
            }
        }
    }
}

extern "C" void kernel_launch(void* const* d_in, const int* in_sizes, int n_in, void* d_out, int out_size, void* d_ws, size_t ws_size, hipStream_t stream) {
    static int grid = 0;
    if (grid == 0) {
        if (n_in != 30 || in_sizes[0] != T * DM || out_size != T * DM || ws_size < WS_END) { fprintf(stderr, "kernel_launch: unexpected shapes (n_in %d, in0 %d, out %d, ws %zu); nothing launched\n", n_in, n_in > 0 ? in_sizes[0] : -1, out_size, ws_size); grid = -1; return; }
        int dev = 0, cus = 0, per_cu = 0;
        if (hipGetDevice(&dev) != hipSuccess || hipDeviceGetAttribute(&cus, hipDeviceAttributeMultiprocessorCount, dev) != hipSuccess) { grid = -1; return; }
        if (hipFuncSetAttribute((const void*)fwd_kernel, hipFuncAttributeMaxDynamicSharedMemorySize, LDS_BYTES) != hipSuccess) { fprintf(stderr, "kernel_launch: hipFuncSetAttribute failed\n"); grid = -1; return; }
        if (hipOccupancyMaxActiveBlocksPerMultiprocessor(&per_cu, (const void*)fwd_kernel, NWAVES * 64, LDS_BYTES) != hipSuccess || per_cu < 1) { fprintf(stderr, "kernel_launch: occupancy query says %d\n", per_cu); }
        (void)hipGetLastError();
        grid = cus;
    }
    if (grid < 0) return;
    if (hipMemsetAsync((char*)d_ws + WS_CTL, 0, CTL_ZERO_BYTES, stream) != hipSuccess) return;
    Args a{};
    for (int i = 0; i < 30; ++i) a.in[i] = (const float*)d_in[i];
    a.out = (float*)d_out; a.ws = (unsigned char*)d_ws;
    hipLaunchKernelGGL(fwd_kernel, dim3(grid), dim3(NWAVES * 64), LDS_BYTES, stream, a);
}
```
